# Optimizing an MI355X kernel written in HIP

```python
import jax, jax.numpy as jnp
from jax import lax
import numpy as np

D_MODEL = 1024
BATCH = 1
SEQ = 16384
DEPTH = 2

LRU_WIDTH = D_MODEL
LRU_HEADS = 8
LRU_HEAD_DIM = LRU_WIDTH // LRU_HEADS
LRU_CONV = 4
LRU_C = 8.0
SC_WIDTH = D_MODEL
SC_HEADS = 8
SC_CONV = 3
POOL_WIDTH = 2 * D_MODEL
POOL_WINDOWS = (2, 4, 8, 16)
POOL_GROUPS = len(POOL_WINDOWS)
POOL_GROUP_DIM = POOL_WIDTH // POOL_GROUPS
EVEN_IN = 2 * LRU_WIDTH + 4 * SC_WIDTH
EVEN_SPLITS = (LRU_WIDTH, 2 * LRU_WIDTH, 2 * LRU_WIDTH + SC_WIDTH,
               2 * LRU_WIDTH + 2 * SC_WIDTH, 2 * LRU_WIDTH + 3 * SC_WIDTH)
N_EVEN = (DEPTH + 1) // 2
N_ODD = DEPTH // 2
EPS = 1e-6

kernel_name = "hybrid_rglru_shortconv_pool_adaln"


def rmsnorm(x, g):
    xf = x.astype(jnp.float32)
    y = xf * lax.rsqrt(jnp.mean(xf * xf, axis=-1, keepdims=True) + EPS)
    return (y * g.astype(jnp.float32)).astype(x.dtype)


def causal_dwconv(x, w, b=None):
    k_width = w.shape[0]
    s = x.shape[1]
    xp = jnp.pad(x, ((0, 0), (k_width - 1, 0), (0, 0)))
    y = xp[:, 0:s] * w[0]
    for k in range(1, k_width):
        y = y + xp[:, k:k + s] * w[k]
    if b is not None:
        y = y + b
    return y


def rg_lru(x, w_a, b_a, w_x, b_x, lam):
    bsz, s, width = x.shape
    xh = x.reshape(bsz, s, LRU_HEADS, LRU_HEAD_DIM)
    r = jax.nn.sigmoid(jnp.einsum('bshi,hij->bshj', xh, w_a).reshape(bsz, s, width) + b_a)
    i = jax.nn.sigmoid(jnp.einsum('bshi,hij->bshj', xh, w_x).reshape(bsz, s, width) + b_x)
    log_a = -LRU_C * r.astype(jnp.float32) * jax.nn.softplus(-lam.astype(jnp.float32))
    a = jnp.exp(log_a)
    mult = jnp.sqrt(-jnp.expm1(2.0 * log_a))
    reset = (jnp.arange(s) == 0)[None, :, None]
    mult = jnp.where(reset, jnp.ones_like(mult), mult)
    u = mult * (i.astype(jnp.float32) * x.astype(jnp.float32))

    def combine(left, right):
        a_l, b_l = left
        a_r, b_r = right
        return a_l * a_r, a_r * b_l + b_r

    _, h = lax.associative_scan(combine, (a, u), axis=1)
    return h.astype(x.dtype)


def causal_window_mean(x, window):
    s = x.shape[1]
    cs = jnp.cumsum(x.astype(jnp.float32), axis=1)
    lag = jnp.pad(cs, ((0, 0), (window, 0), (0, 0)))[:, :s]
    count = jnp.minimum(jnp.arange(1, s + 1), window).astype(jnp.float32)[None, :, None]
    return ((cs - lag) / count).astype(x.dtype)


def even_mixer(h, w_in, conv_w, conv_b, w_a, b_a, w_x, b_x, lam, sc_conv_w, w_out):
    proj = h @ w_in
    xa, ga, gb_post, gc_pre, v, gb = jnp.split(proj, EVEN_SPLITS, axis=-1)
    ya = rg_lru(causal_dwconv(xa, conv_w, conv_b), w_a, b_a, w_x, b_x, lam)
    yb = gb_post * causal_dwconv(gc_pre * v, sc_conv_w)
    y = jnp.concatenate([ya * jax.nn.silu(ga), yb * jax.nn.silu(gb)], axis=-1)
    return y @ w_out


def odd_mixer(h, w_in, w_grp, b_grp, scale, w_out):
    bsz, s, _ = h.shape
    proj = h @ w_in
    v, g = jnp.split(proj, 2, axis=-1)
    vg = v.reshape(bsz, s, POOL_GROUPS, POOL_GROUP_DIM)
    pooled = jnp.stack([causal_window_mean(vg[:, :, k], POOL_WINDOWS[k])
                        for k in range(POOL_GROUPS)], axis=2)
    mixed = jnp.einsum('bsgc,gcd->bsgd', pooled - vg, w_grp).reshape(bsz, s, POOL_WIDTH) + b_grp
    y = mixed * scale * jax.nn.silu(g)
    return y @ w_out


def setup_inputs(seed: int = 0) -> dict:
    key = jax.random.key(seed)
    ks = jax.random.split(key, 21)
    f32 = jnp.float32
    nrm = lambda k, shape, s: jax.random.normal(k, shape, f32) * s
    d = D_MODEL
    u = jax.random.uniform(ks[12], (N_EVEN, LRU_WIDTH), f32, minval=0.9, maxval=0.999)
    return {
        "x": nrm(ks[0], (BATCH, SEQ, d), 1.0),
        "c": nrm(ks[1], (BATCH, d), 1.0),
        "norm_g": 1.0 + nrm(ks[2], (DEPTH, d), 0.05),
        "mod_w": nrm(ks[3], (DEPTH, d, 3 * d), 0.5 * d ** -0.5),
        "mod_b": nrm(ks[4], (DEPTH, 3 * d), 0.02),
        "hy_w_in": nrm(ks[5], (N_EVEN, d, EVEN_IN), d ** -0.5),
        "hy_conv_w": nrm(ks[6], (N_EVEN, LRU_CONV, LRU_WIDTH), LRU_CONV ** -0.5),
        "hy_conv_b": nrm(ks[7], (N_EVEN, LRU_WIDTH), 0.02),
        "lru_w_a": nrm(ks[8], (N_EVEN, LRU_HEADS, LRU_HEAD_DIM, LRU_HEAD_DIM), LRU_HEAD_DIM ** -0.5),
        "lru_b_a": nrm(ks[9], (N_EVEN, LRU_WIDTH), 0.02),
        "lru_w_x": nrm(ks[10], (N_EVEN, LRU_HEADS, LRU_HEAD_DIM, LRU_HEAD_DIM), LRU_HEAD_DIM ** -0.5),
        "lru_b_x": nrm(ks[11], (N_EVEN, LRU_WIDTH), 0.02),
        "lru_lambda": jnp.log(u) - jnp.log1p(-u),
        "sc_conv_w": nrm(ks[13], (N_EVEN, SC_CONV, SC_WIDTH), SC_CONV ** -0.5),
        "hy_w_out": nrm(ks[14], (N_EVEN, LRU_WIDTH + SC_WIDTH, d), (LRU_WIDTH + SC_WIDTH) ** -0.5),
        "pool_w_in": nrm(ks[15], (N_ODD, d, 2 * POOL_WIDTH), d ** -0.5),
        "pool_w_grp": nrm(ks[16], (N_ODD, POOL_GROUPS, POOL_GROUP_DIM, POOL_GROUP_DIM), POOL_GROUP_DIM ** -0.5),
        "pool_b_grp": nrm(ks[17], (N_ODD, POOL_WIDTH), 0.02),
        "pool_scale": 1.0 + nrm(ks[18], (N_ODD, POOL_WIDTH), 0.1),
        "pool_w_out": nrm(ks[19], (N_ODD, POOL_WIDTH, d), POOL_WIDTH ** -0.5),
        "final_g": 1.0 + nrm(ks[20], (d,), 0.05),
    }


def reference(x, c, norm_g, mod_w, mod_b, hy_w_in, hy_conv_w, hy_conv_b, lru_w_a, lru_b_a,
              lru_w_x, lru_b_x, lru_lambda, sc_conv_w, hy_w_out, pool_w_in, pool_w_grp,
              pool_b_grp, pool_scale, pool_w_out, final_g):
    c_act = jax.nn.silu(c)
    for layer in range(DEPTH):
        mod = c_act @ mod_w[layer] + mod_b[layer]
        shift, scale, gate = jnp.split(mod, 3, axis=-1)
        h = rmsnorm(x, norm_g[layer]) * (1.0 + scale[:, None, :]) + shift[:, None, :]
        if layer % 2 == 0:
            e = layer // 2
            y = even_mixer(h, hy_w_in[e], hy_conv_w[e], hy_conv_b[e], lru_w_a[e], lru_b_a[e],
                           lru_w_x[e], lru_b_x[e], lru_lambda[e], sc_conv_w[e], hy_w_out[e])
        else:
            o = layer // 2
            y = odd_mixer(h, pool_w_in[o], pool_w_grp[o], pool_b_grp[o], pool_scale[o], pool_w_out[o])
        x = x + gate[:, None, :] * y
    return rmsnorm(x, final_g)
```

```cpp
#include <hip/hip_runtime.h>
#include <hip/hip_cooperative_groups.h>
#include <cstdio>
#include <cstdint>
namespace cg = cooperative_groups;
#ifndef MK_N_LAUNCHES
#define MK_N_LAUNCHES 1
#endif
namespace pg8 {
#define PG8_LAS __attribute__((address_space(3)))
typedef unsigned short bf16_t;
typedef short bf16x8 __attribute__((ext_vector_type(8)));
typedef float f32x4 __attribute__((ext_vector_type(4)));
typedef unsigned u32x4 __attribute__((ext_vector_type(4)));
constexpr int BM = 256, BK = 64, HALF = 128, HTB = HALF * BK * 2  , STAGE_BYTES = 8 * HTB, NXCD = 8, WGM = 8;

__host__ __device__ __forceinline__ int lds_byte(int r, int c) { const int st = (r >> 4) * 2 + (c >> 5), rr = r & 15, cc = c & 31, ob = rr * 64 + cc * 2; return st * 1024 + (ob ^ (((ob >> 9) & 1) << 5)); }
__host__ __device__ __forceinline__ void stage_rc(int b, int& R, int& C) { const int st = b / 1024, sb = b % 1024, swz = sb ^ (((sb >> 9) & 1) << 5); R = (st >> 1) * 16 + swz / 64; C = (st & 1) * 32 + (swz % 64) / 2; }
__host__ __device__ __forceinline__ int perm32(int rho) { const int n = rho >> 4, i = rho & 15; return 8 * (i >> 2) + 4 * n + (i & 3); }

struct Unit { int pm, pn; };
struct Gemm { const bf16_t* A; const bf16_t* Bt; int M, N, K, lda, ldb, a_pn_shift, a_pn_bytes; };

struct StaticOrder {
    int nM, nN, nwg, G, c;
    __host__ __device__ void init(int M, int N, int G_, int c_) { nM = M / BM; nN = N / BM; nwg = nM * nN; G = G_; c = c_; }
    __host__ __device__ bool next(int i, Unit& u) const {
        const long L = (long)i * G + c; if (L >= nwg) return false;
        int wgid = (int)L; { const int q = nwg / NXCD, r = nwg % NXCD, xcd = wgid % NXCD, off = wgid / NXCD; wgid = (xcd < r ? xcd * (q + 1) : r * (q + 1) + (xcd - r) * q) + off; }
        const int nig = WGM * nN, gid = wgid / nig, fm = gid * WGM, gsz = (nM - fm) < WGM ? (nM - fm) : WGM;
        u.pm = fm + ((wgid % nig) % gsz); u.pn = (wgid % nig) / gsz; return true;
    }
    __device__ __forceinline__ void a_ready(const Unit&) const {}
    __device__ __forceinline__ void done(const Unit&) const {}
};
__device__ __forceinline__ unsigned cvt_pk_bf16(float lo, float hi) { unsigned r; asm volatile("v_cvt_pk_bf16_f32 %0, %1, %2" : "=v"(r) : "v"(lo), "v"(hi)); return r; }
}
namespace pg8 {
struct EpiBf16P {
    static constexpr bool PERM = true, AFTER_DRAIN = false;
    bf16_t* O; int ldc;
    __device__ __forceinline__ void operator()(const f32x4 (&acc)[2][2][4][2], const Unit& u, int wr, int wc, int fr, int fq) const {
        const int row0 = u.pm * BM + wr * 64 + fr, col0 = u.pn * BM + wc * 32 + 8 * fq;
#pragma unroll
        for (int ai = 0; ai < 2; ++ai)
#pragma unroll
            for (int m = 0; m < 4; ++m) { bf16_t* rowp = O + (size_t)(row0 + ai * HALF + m * 16) * ldc + col0;
#pragma unroll
                for (int bj = 0; bj < 2; ++bj) { const f32x4 v0 = acc[ai][bj][m][0], v1 = acc[ai][bj][m][1];
                    u32x4 w; w.x = cvt_pk_bf16(v0[0], v0[1]); w.y = cvt_pk_bf16(v0[2], v0[3]); w.z = cvt_pk_bf16(v1[0], v1[1]); w.w = cvt_pk_bf16(v1[2], v1[3]);
                    *(u32x4*)(rowp + bj * HALF) = w; } }
    }
};
struct EpiResGate {
    static constexpr bool PERM = false, AFTER_DRAIN = false;
    const float* base; float* out; const float* gate; int ldc;
    __device__ __forceinline__ void operator()(const f32x4 (&acc)[2][2][4][2], const Unit& u, int wr, int wc, int fr, int fq) const {
        const int row0 = u.pm * BM + wr * 64 + fr, col0 = u.pn * BM + wc * 32 + 4 * fq;
        f32x4 gv[2][2];
#pragma unroll
        for (int bj = 0; bj < 2; ++bj)
#pragma unroll
            for (int n = 0; n < 2; ++n) gv[bj][n] = *(const f32x4*)(gate + col0 + bj * HALF + n * 16);
#pragma unroll
        for (int ai = 0; ai < 2; ++ai)
#pragma unroll
            for (int m = 0; m < 4; ++m) { const size_t off = (size_t)(row0 + ai * HALF + m * 16) * ldc + col0;
#pragma unroll
                for (int bj = 0; bj < 2; ++bj)
#pragma unroll
                    for (int n = 0; n < 2; ++n) { const f32x4 bs = *(const f32x4*)(base + off + bj * HALF + n * 16); *(f32x4*)(out + off + bj * HALF + n * 16) = bs + gv[bj][n] * acc[ai][bj][m][n]; }
                asm volatile("" ::: "memory"); }
    }
};
struct EpiGrp {
    static constexpr bool PERM = true, AFTER_DRAIN = false;
    bf16_t* G; int ldc; const float* bias; const float* scale;
    __device__ __forceinline__ void operator()(const f32x4 (&acc)[2][2][4][2], const Unit& u, int wr, int wc, int fr, int fq) const {
        const int row0 = u.pm * BM + wr * 64 + fr, col0 = u.pn * BM + wc * 32 + 8 * fq;
        f32x4 bv[2][2], sv[2][2];
#pragma unroll
        for (int bj = 0; bj < 2; ++bj)
#pragma unroll
            for (int n = 0; n < 2; ++n) { bv[bj][n] = *(const f32x4*)(bias + col0 + bj * HALF + 4 * n); sv[bj][n] = *(const f32x4*)(scale + col0 + bj * HALF + 4 * n); }
#pragma unroll
        for (int ai = 0; ai < 2; ++ai)
#pragma unroll
            for (int m = 0; m < 4; ++m) { bf16_t* rowp = G + (size_t)(row0 + ai * HALF + m * 16) * ldc + col0;
#pragma unroll
                for (int bj = 0; bj < 2; ++bj) { const u32x4 gw = *(const u32x4*)(rowp + bj * HALF);
                    const float g0 = __uint_as_float(gw.x << 16), g1 = __uint_as_float(gw.x & 0xffff0000u), g2 = __uint_as_float(gw.y << 16), g3 = __uint_as_float(gw.y & 0xffff0000u);
                    const float g4 = __uint_as_float(gw.z << 16), g5 = __uint_as_float(gw.z & 0xffff0000u), g6 = __uint_as_float(gw.w << 16), g7 = __uint_as_float(gw.w & 0xffff0000u);
                    const f32x4 s0 = (f32x4){g0, g1, g2, g3}, s1 = (f32x4){g4, g5, g6, g7};
                    f32x4 e0, e1;
#pragma unroll
                    for (int j = 0; j < 4; ++j) { e0[j] = s0[j] * __builtin_amdgcn_rcpf(1.0f + __builtin_amdgcn_exp2f(-s0[j] * 1.4426950408889634f)); e1[j] = s1[j] * __builtin_amdgcn_rcpf(1.0f + __builtin_amdgcn_exp2f(-s1[j] * 1.4426950408889634f)); }
                    const f32x4 v0 = (acc[ai][bj][m][0] + bv[bj][0]) * sv[bj][0] * e0, v1 = (acc[ai][bj][m][1] + bv[bj][1]) * sv[bj][1] * e1;
                    u32x4 w; w.x = cvt_pk_bf16(v0[0], v0[1]); w.y = cvt_pk_bf16(v0[2], v0[3]); w.z = cvt_pk_bf16(v1[0], v1[1]); w.w = cvt_pk_bf16(v1[2], v1[3]);
                    *(u32x4*)(rowp + bj * HALF) = w; } }
    }
};
template <class Epi, class Sched, bool ALIGN_EPI = false, bool SP2 = false>
__device__ __forceinline__ void gemm_phase(PG8_LAS unsigned char* lds, const Gemm g, const Sched& S, const Epi& E) {
    const int tid = threadIdx.x, wid = __builtin_amdgcn_readfirstlane(tid >> 6), lane = tid & 63, wr = wid >> 2, wc = wid & 3, fr = lane & 15, fq = lane >> 4;
    const int K = g.K, nt = K / BK, lda = g.lda, ldb = g.ldb;
    unsigned voffA[2], voffB[2];
#pragma unroll
    for (int i = 0; i < 2; ++i) { int R, C; stage_rc(tid * 16 + i * 8192, R, C); const int Rb = Epi::PERM ? ((R & ~31) + perm32(R & 31)) : R;
        voffA[i] = (unsigned)(R * lda + C) * 2u; voffB[i] = (unsigned)(Rb * ldb + C) * 2u; }
    const size_t kstep = (size_t)(BK * 2);
    const size_t hstepA = (size_t)HALF * lda * 2, hstepB = (size_t)HALF * ldb * 2;
    const size_t tstepA = 2 * hstepA, tstepB = 2 * hstepB;
    const unsigned ldsw = (unsigned)wid * 1024u;
    const int aoff = lds_byte(wr * 64 + fr, fq * 8), boff = lds_byte(wc * 32 + fr, fq * 8);
#define PG8_SA(b, h) (((b) * 2 + (h)) * HTB)
#define PG8_SB(b, h) ((4 + (b) * 2 + (h)) * HTB)
#define PG8_STAGE(bufoff, gbase, voff) do { _Pragma("unroll") for (int _i = 0; _i < 2; ++_i) \
        __builtin_amdgcn_global_load_lds((const unsigned*)((const char*)(gbase) + (voff)[_i]), (PG8_LAS unsigned*)(lds + (bufoff) + ldsw + _i * 8192), 16, 0, 0); } while (0)
#define PG8_LDA(dst, b, h) do { _Pragma("unroll") for (int m = 0; m < 4; ++m) _Pragma("unroll") for (int k = 0; k < 2; ++k) dst[m][k] = *(const PG8_LAS bf16x8*)(lds + PG8_SA(b, h) + aoff + m * 2048 + k * 1024); } while (0)
#define PG8_LDB(dst, b, h) do { _Pragma("unroll") for (int n = 0; n < 2; ++n) _Pragma("unroll") for (int k = 0; k < 2; ++k) dst[n][k] = *(const PG8_LAS bf16x8*)(lds + PG8_SB(b, h) + boff + n * 2048 + k * 1024); } while (0)
#define PG8_MMA(ai, bj, At, Bt) do { __builtin_amdgcn_s_setprio(1); _Pragma("unroll") for (int m = 0; m < 4; ++m) _Pragma("unroll") for (int n = 0; n < 2; ++n) _Pragma("unroll") for (int k = 0; k < 2; ++k) \
        acc[ai][bj][m][n] = __builtin_amdgcn_mfma_f32_16x16x32_bf16(Bt[n][k], At[m][k], acc[ai][bj][m][n], 0, 0, 0); __builtin_amdgcn_s_setprio(0); } while (0)
#define PG8_WAIT_V(n) asm volatile("s_waitcnt vmcnt(" #n ")" ::: "memory")
#define PG8_WAIT_L(n) asm volatile("s_waitcnt lgkmcnt(" #n ")" ::: "memory")
#define PG8_BAR __builtin_amdgcn_s_barrier()
#define PG8_SCHED __builtin_amdgcn_sched_barrier(0)
    Unit cur, nxt; int ui = 0;
    if (!S.next(0, cur)) return;
    f32x4 acc[2][2][4][2];
#pragma unroll
    for (int a = 0; a < 2; ++a)
#pragma unroll
        for (int b = 0; b < 2; ++b)
#pragma unroll
            for (int m = 0; m < 4; ++m)
#pragma unroll
                for (int n = 0; n < 2; ++n) acc[a][b][m][n] = (f32x4){0.f, 0.f, 0.f, 0.f};
    bf16x8 At[4][2], B0[2][2], B1[2][2];
    const char* cA = (const char*)g.A + (size_t)cur.pm * tstepA + (size_t)(cur.pn >> g.a_pn_shift) * g.a_pn_bytes; const char* cB = (const char*)g.Bt + (size_t)cur.pn * tstepB;
    S.a_ready(cur);
    if constexpr (SP2) {
        PG8_STAGE(PG8_SB(0, 0), cB, voffB); PG8_STAGE(PG8_SB(0, 1), cB + hstepB, voffB); PG8_STAGE(PG8_SA(0, 0), cA, voffA); PG8_STAGE(PG8_SA(0, 1), cA + hstepA, voffA);
        if (wr == 1) PG8_BAR;
        PG8_WAIT_V(2); PG8_BAR;
        PG8_STAGE(PG8_SB(1, 0), cB + kstep, voffB); PG8_STAGE(PG8_SA(1, 0), cA + kstep, voffA); PG8_STAGE(PG8_SB(1, 1), cB + hstepB + kstep, voffB);
        PG8_WAIT_V(6); PG8_BAR;
    } else {
        PG8_STAGE(PG8_SB(0, 0), cB, voffB); PG8_STAGE(PG8_SA(0, 0), cA, voffA); PG8_STAGE(PG8_SB(0, 1), cB + hstepB, voffB); PG8_STAGE(PG8_SA(0, 1), cA + hstepA, voffA);
        if (wr == 1) PG8_BAR;
        PG8_WAIT_V(4); PG8_BAR;
        PG8_STAGE(PG8_SB(1, 0), cB + kstep, voffB); PG8_STAGE(PG8_SA(1, 0), cA + kstep, voffA); PG8_STAGE(PG8_SB(1, 1), cB + hstepB + kstep, voffB);
        PG8_WAIT_V(6); PG8_BAR;
    }
    for (;;) {
        const bool has_next = S.next(ui + 1, nxt);
        const char* nA = has_next ? (const char*)g.A + (size_t)nxt.pm * tstepA + (size_t)(nxt.pn >> g.a_pn_shift) * g.a_pn_bytes : cA; const char* nB = has_next ? (const char*)g.Bt + (size_t)nxt.pn * tstepB : cB;
        for (int t = 0; t < nt; t += 2) {
            const bool last = (t == nt - 2);
            const char* a1 = cA + (size_t)(t + 1) * kstep;
            const char* a2 = last ? nA : cA + (size_t)(t + 2) * kstep; const char* b2 = last ? nB : cB + (size_t)(t + 2) * kstep;
            const char* a3 = a2 + kstep; const char* b3 = b2 + kstep;
            if (last && has_next) S.a_ready(nxt);
            if constexpr (SP2) {
            PG8_LDB(B0, 0, 0); PG8_LDB(B1, 0, 1); PG8_SCHED; PG8_LDA(At, 0, 0); PG8_STAGE(PG8_SA(1, 1), a1 + hstepA, voffA);
            PG8_WAIT_V(8); PG8_WAIT_L(0); PG8_BAR; PG8_MMA(0, 0, At, B0); PG8_MMA(0, 1, At, B1); PG8_BAR; PG8_SCHED;
            PG8_LDA(At, 0, 1); PG8_STAGE(PG8_SB(0, 0), b2, voffB); PG8_STAGE(PG8_SB(0, 1), b2 + hstepB, voffB); PG8_STAGE(PG8_SA(0, 0), a2, voffA);
            PG8_WAIT_V(8); PG8_WAIT_L(0); PG8_BAR; PG8_MMA(1, 0, At, B0); PG8_MMA(1, 1, At, B1); PG8_BAR; PG8_SCHED;
            PG8_LDB(B0, 1, 0); PG8_LDB(B1, 1, 1); PG8_SCHED; PG8_LDA(At, 1, 0); PG8_STAGE(PG8_SA(0, 1), a2 + hstepA, voffA);
            PG8_WAIT_V(8); PG8_WAIT_L(0); PG8_BAR; PG8_MMA(0, 0, At, B0); PG8_MMA(0, 1, At, B1); PG8_BAR; PG8_SCHED;
            PG8_LDA(At, 1, 1); PG8_STAGE(PG8_SB(1, 0), b3, voffB); PG8_STAGE(PG8_SB(1, 1), b3 + hstepB, voffB); PG8_STAGE(PG8_SA(1, 0), a3, voffA);
            PG8_WAIT_V(8); PG8_WAIT_L(0); PG8_BAR; PG8_MMA(1, 0, At, B0); PG8_MMA(1, 1, At, B1); PG8_BAR; PG8_SCHED;
            } else {
            PG8_LDB(B0, 0, 0); PG8_SCHED; PG8_LDA(At, 0, 0); PG8_STAGE(PG8_SA(1, 1), a1 + hstepA, voffA);
            PG8_WAIT_L(8); PG8_BAR; PG8_WAIT_L(0); PG8_MMA(0, 0, At, B0); PG8_BAR; PG8_SCHED;
            PG8_LDB(B1, 0, 1); PG8_STAGE(PG8_SB(0, 0), b2, voffB);
            PG8_BAR; PG8_WAIT_L(0); PG8_MMA(0, 1, At, B1); PG8_BAR;
            PG8_LDA(At, 0, 1); PG8_STAGE(PG8_SA(0, 0), a2, voffA);
            PG8_BAR; PG8_WAIT_L(0); PG8_MMA(1, 0, At, B0); PG8_BAR; PG8_SCHED;
            PG8_STAGE(PG8_SB(0, 1), b2 + hstepB, voffB);
            PG8_WAIT_V(6); PG8_BAR; PG8_MMA(1, 1, At, B1); PG8_BAR;
            PG8_LDB(B0, 1, 0); PG8_SCHED; PG8_LDA(At, 1, 0); PG8_STAGE(PG8_SA(0, 1), a2 + hstepA, voffA);
            PG8_WAIT_L(8); PG8_BAR; PG8_WAIT_L(0); PG8_MMA(0, 0, At, B0); PG8_BAR; PG8_SCHED;
            PG8_LDB(B1, 1, 1); PG8_STAGE(PG8_SB(1, 0), b3, voffB);
            PG8_BAR; PG8_WAIT_L(0); PG8_MMA(0, 1, At, B1); PG8_BAR;
            PG8_LDA(At, 1, 1); PG8_STAGE(PG8_SA(1, 0), a3, voffA);
            PG8_BAR; PG8_WAIT_L(0); PG8_MMA(1, 0, At, B0); PG8_BAR; PG8_SCHED;
            PG8_STAGE(PG8_SB(1, 1), b3 + hstepB, voffB);
            PG8_WAIT_V(6); PG8_BAR; PG8_MMA(1, 1, At, B1); PG8_BAR;
            }
        }
        if constexpr (ALIGN_EPI) { if (wr == 0) PG8_BAR; }
        if constexpr (!Epi::AFTER_DRAIN) { E(acc, cur, wr, wc, fr, fq); S.done(cur); }
        if (!has_next) break;
#pragma unroll
        for (int a = 0; a < 2; ++a)
#pragma unroll
            for (int b = 0; b < 2; ++b)
#pragma unroll
                for (int m = 0; m < 4; ++m)
#pragma unroll
                    for (int n = 0; n < 2; ++n) acc[a][b][m][n] = (f32x4){0.f, 0.f, 0.f, 0.f};
        cur = nxt; cA = nA; cB = nB; ++ui;
        if constexpr (ALIGN_EPI) { if (wr == 1) PG8_BAR; }
    }
    PG8_WAIT_V(0);
    if constexpr (!ALIGN_EPI) { if (wr == 0) PG8_BAR; }
    PG8_BAR;
    if constexpr (Epi::AFTER_DRAIN) { E.fused(acc, cur, wr, wc, fr, fq, lds, wid, lane); S.done(cur); }
#undef PG8_SA
#undef PG8_SB
#undef PG8_STAGE
#undef PG8_LDA
#undef PG8_LDB
#undef PG8_MMA
#undef PG8_WAIT_V
#undef PG8_WAIT_L
#undef PG8_BAR
#undef PG8_SCHED
}
}
constexpr int S = 16384, D = 1024, EIN = 6144, PW = 2048, NPH = 12;
constexpr float EPS = 1e-6f, LOG2E = 1.4426950408889634f;
constexpr size_t MiB = 1u << 20;
constexpr size_t WS_MOD = 0;
constexpr size_t WS_AGG = 1 * MiB;
constexpr size_t WS_WIN = 4 * MiB;
constexpr size_t WS_WOUT = 16 * MiB;
constexpr size_t WS_PWIN = 20 * MiB;
constexpr size_t WS_PGRP = 28 * MiB;
constexpr size_t WS_PWOUT = 30 * MiB;
constexpr size_t WS_LWA = 34 * MiB;
constexpr size_t WS_LWX = 34 * MiB + 512 * 1024;
constexpr size_t WS_PROJ0 = 36 * MiB;
constexpr size_t WS_H1 = 224 * MiB;
constexpr size_t WS_PROJ1 = 36 * MiB;
constexpr size_t WS_DP = 164 * MiB;
constexpr int LDS_BYTES = 147456;

#define LAS __attribute__((address_space(3)))
typedef unsigned short bf16;
typedef float f32x4 __attribute__((ext_vector_type(4)));
typedef unsigned u32x4 __attribute__((ext_vector_type(4)));
typedef unsigned u32x2 __attribute__((ext_vector_type(2)));
typedef short bf16x8 __attribute__((ext_vector_type(8)));
using pg8::cvt_pk_bf16;
__device__ __forceinline__ float bf2f(unsigned short b) { return __uint_as_float(((unsigned)b) << 16); }
__device__ __forceinline__ float bflo(unsigned w) { return __uint_as_float(w << 16); }
__device__ __forceinline__ float bfhi(unsigned w) { return __uint_as_float(w & 0xffff0000u); }
__device__ __forceinline__ unsigned short f2bf(float f) { unsigned u = __float_as_uint(f); return (unsigned short)((u + 0x7fffu + ((u >> 16) & 1u)) >> 16); }
__device__ __forceinline__ float sigmoidf_(float x) { return __builtin_amdgcn_rcpf(1.0f + __builtin_amdgcn_exp2f(-x * LOG2E)); }
__device__ __forceinline__ float siluf_(float x) { return x * sigmoidf_(x); }
__device__ __forceinline__ float wave_sum(float v) {
#pragma unroll
    for (int o = 1; o < 64; o <<= 1) v += __shfl_xor(v, o);
    return v;
}
__device__ __forceinline__ void unpack8(const u32x4 w, float (&f)[8]) { f[0] = bflo(w.x); f[1] = bfhi(w.x); f[2] = bflo(w.y); f[3] = bfhi(w.y); f[4] = bflo(w.z); f[5] = bfhi(w.z); f[6] = bflo(w.w); f[7] = bfhi(w.w); }
__device__ __forceinline__ u32x4 pack8(const float (&f)[8]) { u32x4 w; w.x = cvt_pk_bf16(f[0], f[1]); w.y = cvt_pk_bf16(f[2], f[3]); w.z = cvt_pk_bf16(f[4], f[5]); w.w = cvt_pk_bf16(f[6], f[7]); return w; }

struct Args { const float* in[21]; float* out; unsigned char* ws; int ph_lo, ph_hi; };
enum { I_X = 0, I_C, I_NORMG, I_MODW, I_MODB, I_HYWIN, I_CONVW, I_CONVB, I_LWA, I_LBA, I_LWX, I_LBX, I_LAM, I_SCW, I_HYWOUT, I_PWIN, I_PGRP, I_PBGRP, I_PSCALE, I_PWOUT, I_FINALG };

__device__ __forceinline__ void transpose_item(const float* W, int N, int k0, int n0, bf16* WT, int ldt, int drow0, LAS float* scr, int lane) {
#pragma unroll 8
    for (int i = 0; i < 32; ++i) { const int kk = 2 * i + (lane >> 5); scr[kk * 33 + (lane & 31)] = W[(size_t)(k0 + kk) * N + n0 + (lane & 31)]; }
    asm volatile("s_waitcnt lgkmcnt(0)" ::: "memory");
    const int c = lane & 7;
#pragma unroll
    for (int j = 0; j < 4; ++j) { const int n = (lane >> 3) + 8 * j; const LAS float* s = scr + (8 * c) * 33 + n;
        u32x4 o; o.x = cvt_pk_bf16(s[0 * 33], s[1 * 33]); o.y = cvt_pk_bf16(s[2 * 33], s[3 * 33]); o.z = cvt_pk_bf16(s[4 * 33], s[5 * 33]); o.w = cvt_pk_bf16(s[6 * 33], s[7 * 33]);
        *(u32x4*)(WT + (size_t)(drow0 + n) * ldt + k0 + 8 * c) = o; }
    asm volatile("s_waitcnt lgkmcnt(0)" ::: "memory");
}
__device__ __forceinline__ void p0_prep(const Args& a, LAS unsigned char* lds) {
    const int tid = threadIdx.x, lane = tid & 63, w = __builtin_amdgcn_readfirstlane(tid >> 6);
    unsigned char* ws = a.ws;
    { LAS float* red = (LAS float*)lds; float* mod = (float*)(ws + WS_MOD);
      for (int it = blockIdx.x; it < 96; it += gridDim.x) {
        const int l = it / 48, cgp = it % 48; const float* Wp = a.in[I_MODW] + (size_t)l * D * 3072 + 64 * cgp + lane; const float* cp = a.in[I_C];
        float acc = 0.f;
#pragma unroll 8
        for (int kk = 0; kk < 128; ++kk) { const int k = 128 * w + kk; const float cv = cp[k]; acc += siluf_(cv) * Wp[(size_t)k * 3072]; }
        red[w * 64 + lane] = acc; __syncthreads();
        if (w == 0) { float s = 0.f;
#pragma unroll
            for (int i = 0; i < 8; ++i) s += red[i * 64 + lane];
            mod[l * 3072 + 64 * cgp + lane] = s + a.in[I_MODB][l * 3072 + 64 * cgp + lane]; }
        __syncthreads(); } }
    LAS float* scr = (LAS float*)(lds + w * 16384);
    const int gw = blockIdx.x * 8 + w, NGW = gridDim.x * 8;
    constexpr int I0 = 16 * 192, I1 = 32 * 32, I2 = 16 * 128, I3 = 4 * 128, I4 = 32 * 32, I5 = 16 * 8, NIT = I0 + I1 + I2 + I3 + I4 + I5;
    for (int it = gw; it < NIT; it += NGW) {
        int r = it;
        if (r < I0) { const int kb = r / 192, nb = r % 192, n0 = 32 * nb, sb = n0 >> 10; const int db = (sb == 0) ? 0 : (sb == 1) ? 1 : (sb == 5) ? 2 : sb + 1;
            transpose_item(a.in[I_HYWIN], EIN, 64 * kb, n0, (bf16*)(ws + WS_WIN), D, db * 1024 + (n0 & 1023), scr, lane); continue; } r -= I0;
        if (r < I1) { const int kb = r / 32, nb = r % 32; transpose_item(a.in[I_HYWOUT], D, 64 * kb, 32 * nb, (bf16*)(ws + WS_WOUT), 2048, 32 * nb, scr, lane); continue; } r -= I1;
        if (r < I2) { const int kb = r / 128, nb = r % 128; transpose_item(a.in[I_PWIN], 4096, 64 * kb, 32 * nb, (bf16*)(ws + WS_PWIN), D, 32 * nb, scr, lane); continue; } r -= I2;
        if (r < I3) { const int g = r / 128, q = r % 128, kb = q / 16, nb = q % 16; transpose_item(a.in[I_PGRP] + (size_t)g * 512 * 512, 512, 64 * kb, 32 * nb, (bf16*)(ws + WS_PGRP) + (size_t)g * 512 * 512, 512, 32 * nb, scr, lane); continue; } r -= I3;
        if (r < I4) { const int kb = r / 32, nb = r % 32; transpose_item(a.in[I_PWOUT], D, 64 * kb, 32 * nb, (bf16*)(ws + WS_PWOUT), 2048, 32 * nb, scr, lane); continue; } r -= I4;
        { const int m = r / 8, q = r % 8, kb = q / 4, nb = q % 4; const float* src = (m < 8 ? a.in[I_LWA] : a.in[I_LWX]) + (size_t)(m & 7) * 128 * 128;
          bf16* dst = (bf16*)(ws + (m < 8 ? WS_LWA : WS_LWX)) + (size_t)(m & 7) * 128 * 128; transpose_item(src, 128, 64 * kb, 32 * nb, dst, 128, 32 * nb, scr, lane); }
    }
}

template <bool FINAL>
__device__ __forceinline__ void rows_phase(const float* X, bf16* H, float* OUT, const float* g, const float* scale, const float* shift) {
    const int tid = threadIdx.x, lane = tid & 63, w = tid >> 6; const int gw = blockIdx.x * 8 + w, NGW = gridDim.x * 8;
    f32x4 gs[4], sh[4];
#pragma unroll
    for (int j = 0; j < 4; ++j) { const int col = 4 * lane + 256 * j; gs[j] = *(const f32x4*)(g + col);
        if (!FINAL) { gs[j] = gs[j] * (*(const f32x4*)(scale + col) + 1.0f); sh[j] = *(const f32x4*)(shift + col); } else sh[j] = (f32x4){0.f, 0.f, 0.f, 0.f}; }
    for (int m = gw; m < S; m += NGW) {
        const f32x4* xr = (const f32x4*)(X + (size_t)m * D) + lane; f32x4 v[4]; float s = 0.f;
#pragma unroll
        for (int j = 0; j < 4; ++j) { v[j] = xr[64 * j]; s += (v[j].x * v[j].x + v[j].y * v[j].y) + (v[j].z * v[j].z + v[j].w * v[j].w); }
        const float rstd = 1.0f / sqrtf(wave_sum(s) * (1.0f / D) + EPS);
        if (FINAL) { f32x4* o = (f32x4*)(OUT + (size_t)m * D) + lane;
#pragma unroll
            for (int j = 0; j < 4; ++j) o[64 * j] = v[j] * rstd * gs[j]; }
        else { u32x2* o = (u32x2*)(H + (size_t)m * D) + lane;
#pragma unroll
            for (int j = 0; j < 4; ++j) { const f32x4 y = v[j] * rstd * gs[j] + sh[j]; u32x2 pk; pk.x = cvt_pk_bf16(y.x, y.y); pk.y = cvt_pk_bf16(y.z, y.w); o[64 * j] = pk; } }
    }
}
template <bool FINAL>
__device__ __forceinline__ void lru_phase(const Args& a, LAS unsigned char* lds) {
    const int tid = threadIdx.x, lane = tid & 63, w = __builtin_amdgcn_readfirstlane(tid >> 6), fr = lane & 15, fq = lane >> 4;
    LAS bf16* Abf = (LAS bf16*)lds;
    LAS float* xcT = (LAS float*)(lds + 17408);
    LAS float* hbuf = (LAS float*)(lds + 17408 + 34816);
    bf16* proj0 = (bf16*)(a.ws + WS_PROJ0);
    const bf16* wa_t = (const bf16*)(a.ws + WS_LWA); const bf16* wx_t = (const bf16*)(a.ws + WS_LWX);
    float* agg = (float*)(a.ws + WS_AGG);
    for (int item = blockIdx.x; item < 256; item += gridDim.x) {
        const int hd = item & 7, sc = item >> 3;
        const int cc = tid & 127, q = tid >> 7, gch = hd * 128 + cc;
        const float cw0 = a.in[I_CONVW][gch], cw1 = a.in[I_CONVW][1024 + gch], cw2 = a.in[I_CONVW][2048 + gch], cw3 = a.in[I_CONVW][3072 + gch], cb = a.in[I_CONVB][gch];
        const int ch = hd * 128 + 16 * w + fr;
        const float ba = a.in[I_LBA][ch], bx = a.in[I_LBX][ch];
        const float k8 = -8.0f * log1pf(expf(-a.in[I_LAM][ch])) * LOG2E;
        bf16x8 wa[4], wx[4];
#pragma unroll
        for (int kk = 0; kk < 4; ++kk) { wa[kk] = *(const bf16x8*)(wa_t + (size_t)(hd * 128 + 16 * w + fr) * 128 + 32 * kk + 8 * fq); wx[kk] = *(const bf16x8*)(wx_t + (size_t)(hd * 128 + 16 * w + fr) * 128 + 32 * kk + 8 * fq); }
        float hin = 0.f, Atot = 1.f;
        if (FINAL) { for (int s = 0; s < sc; ++s) { const float2 ab = *(const float2*)(agg + ((size_t)s * 1024 + ch) * 2); hin = ab.x * hin + ab.y; } }
        for (int st = 0; st < 8; ++st) {
            const int t0 = sc * 512 + st * 64;
            { const int tb = t0 + 16 * q; const bf16* xp = proj0 + (size_t)tb * EIN + gch;
              float x0 = 0.f, x1 = 0.f, x2 = 0.f;
              if (tb > 0) { x0 = bf2f(xp[-3 * EIN]); x1 = bf2f(xp[-2 * EIN]); x2 = bf2f(xp[-1 * EIN]); }
              f32x4 v;
#pragma unroll
              for (int i = 0; i < 16; ++i) { const float x3 = bf2f(xp[(size_t)i * EIN]); const float xc = cw0 * x0 + cw1 * x1 + cw2 * x2 + cw3 * x3 + cb;
                  Abf[(16 * q + i) * 136 + cc] = f2bf(xc); v[i & 3] = xc; if ((i & 3) == 3) *(LAS f32x4*)(xcT + cc * 68 + 16 * q + i - 3) = v;
                  x0 = x1; x1 = x2; x2 = x3; } }
            __syncthreads();
#pragma unroll 1
            for (int mb = 0; mb < 4; ++mb) {
                f32x4 ar = (f32x4){0.f, 0.f, 0.f, 0.f}, ai = (f32x4){0.f, 0.f, 0.f, 0.f};
#pragma unroll
                for (int kk = 0; kk < 4; ++kk) { const bf16x8 af = *(const LAS bf16x8*)(Abf + (16 * mb + fr) * 136 + 32 * kk + 8 * fq);
                    ar = __builtin_amdgcn_mfma_f32_16x16x32_bf16(af, wa[kk], ar, 0, 0, 0); ai = __builtin_amdgcn_mfma_f32_16x16x32_bf16(af, wx[kk], ai, 0, 0, 0); }
                const f32x4 xcv = *(const LAS f32x4*)(xcT + (16 * w + fr) * 68 + 16 * mb + 4 * fq);
                float P[4], H[4];
#pragma unroll
                for (int j = 0; j < 4; ++j) { const float r = sigmoidf_(ar[j] + ba), ig = sigmoidf_(ai[j] + bx); const float av = __builtin_amdgcn_exp2f(r * k8);
                    float mult = sqrtf(fmaxf(1.0f - av * av, 0.f)); if (t0 + 16 * mb + 4 * fq + j == 0) mult = 1.0f;
                    const float uv = mult * ig * xcv[j];
                    if (j == 0) { P[0] = av; H[0] = uv; } else { P[j] = P[j - 1] * av; H[j] = av * H[j - 1] + uv; } }
                float A = P[3], B = H[3];
                float A1 = __shfl_up(A, 16), B1 = __shfl_up(B, 16); if (fq >= 1) { B = A * B1 + B; A = A * A1; }
                A1 = __shfl_up(A, 32); B1 = __shfl_up(B, 32); if (fq >= 2) { B = A * B1 + B; A = A * A1; }
                float Ae = __shfl_up(A, 16), Be = __shfl_up(B, 16); if (fq == 0) { Ae = 1.f; Be = 0.f; }
                const float hs = Ae * hin + Be;
                const float At = __shfl(A, 48 + fr), Bt = __shfl(B, 48 + fr);
                if (FINAL) {
#pragma unroll
                    for (int j = 0; j < 4; ++j) hbuf[(16 * mb + 4 * fq + j) * 132 + 16 * w + fr] = P[j] * hs + H[j]; }
                hin = At * hin + Bt; Atot *= At;
            }
            __syncthreads();
            if (FINAL) {
#pragma unroll 1
                for (int rep = 0; rep < 2; ++rep) { const int id = tid + 512 * rep, t = id >> 4, s = id & 15; const int tg = t0 + t; const int c8 = hd * 128 + 8 * s;
                    bf16* rowp = proj0 + (size_t)tg * EIN + c8;
                    const f32x4 h0 = *(const LAS f32x4*)(hbuf + t * 132 + 8 * s), h1 = *(const LAS f32x4*)(hbuf + t * 132 + 8 * s + 4);
                    float gaf[8], o[8]; unpack8(*(const u32x4*)(rowp + 1024), gaf);
#pragma unroll
                    for (int e = 0; e < 4; ++e) { o[e] = h0[e] * siluf_(gaf[e]); o[4 + e] = h1[e] * siluf_(gaf[4 + e]); }
                    *(u32x4*)(rowp + 1024) = pack8(o);
                    float gbf[8], gpf[8], c0[8], c1[8], c2[8], vv[8], cv[8];
                    unpack8(*(const u32x4*)(rowp + 2048), gbf); unpack8(*(const u32x4*)(rowp + 3072), gpf);
                    unpack8(*(const u32x4*)(rowp + 4096), c2); unpack8(*(const u32x4*)(rowp + 5120), vv);
#pragma unroll
                    for (int e = 0; e < 8; ++e) cv[e] = a.in[I_SCW][2048 + c8 + e] * (c2[e] * vv[e]);
                    if (tg >= 1) { unpack8(*(const u32x4*)(rowp - EIN + 4096), c1); unpack8(*(const u32x4*)(rowp - EIN + 5120), vv);
#pragma unroll
                        for (int e = 0; e < 8; ++e) cv[e] += a.in[I_SCW][1024 + c8 + e] * (c1[e] * vv[e]); }
                    if (tg >= 2) { unpack8(*(const u32x4*)(rowp - 2 * EIN + 4096), c0); unpack8(*(const u32x4*)(rowp - 2 * EIN + 5120), vv);
#pragma unroll
                        for (int e = 0; e < 8; ++e) cv[e] += a.in[I_SCW][c8 + e] * (c0[e] * vv[e]); }
#pragma unroll
                    for (int e = 0; e < 8; ++e) o[e] = gpf[e] * cv[e] * siluf_(gbf[e]);
                    *(u32x4*)(rowp + 2048) = pack8(o);
                }
            }
        }
        if (!FINAL && fq == 0) *(float2*)(agg + ((size_t)sc * 1024 + ch) * 2) = make_float2(Atot, hin);
    }
}

__device__ __forceinline__ void pool_phase(const Args& a) {
    const bf16* proj1 = (const bf16*)(a.ws + WS_PROJ1); bf16* dp = (bf16*)(a.ws + WS_DP);
    for (int task = blockIdx.x * 512 + threadIdx.x; task < 256 * 512; task += gridDim.x * 512) {
        const int strip = task & 255, run = task >> 8, col = 8 * strip, W = 2 << (col >> 9), t0 = run * 32;
        float sum[8], cur[8], old[8];
#pragma unroll
        for (int e = 0; e < 8; ++e) sum[e] = 0.f;
        for (int i = 1; i <= W; ++i) { const int t = t0 - i; if (t >= 0) { unpack8(*(const u32x4*)(proj1 + (size_t)t * 4096 + col), cur);
#pragma unroll
            for (int e = 0; e < 8; ++e) sum[e] += cur[e]; } }
#pragma unroll 4
        for (int i = 0; i < 32; ++i) { const int t = t0 + i; unpack8(*(const u32x4*)(proj1 + (size_t)t * 4096 + col), cur);
#pragma unroll
            for (int e = 0; e < 8; ++e) sum[e] += cur[e];
            if (t - W >= 0) { unpack8(*(const u32x4*)(proj1 + (size_t)(t - W) * 4096 + col), old);
#pragma unroll
                for (int e = 0; e < 8; ++e) sum[e] -= old[e]; }
            const int cnt = (t + 1 < W) ? t + 1 : W; const float inv = 1.0f / (float)cnt; float o[8];
#pragma unroll
            for (int e = 0; e < 8; ++e) o[e] = sum[e] * inv - cur[e];
            *(u32x4*)(dp + (size_t)t * 2048 + col) = pack8(o); }
    }
}

__global__ void __launch_bounds__(512, 2) mk_fwd(Args a) {
    extern __shared__ __attribute__((aligned(16))) unsigned char lds_raw[];
    LAS unsigned char* lds = (LAS unsigned char*)lds_raw;
    cg::grid_group grid = cg::this_grid();
    const int lo = a.ph_lo, hi = a.ph_hi, G = gridDim.x;
    unsigned char* ws = a.ws;
    const float* mod = (const float*)(ws + WS_MOD);
#define IN(k) (lo <= (k) && (k) < hi)
#define SEAM(k) do { if (IN(k) && IN((k) + 1)) grid.sync(); } while (0)
    if (IN(0)) { p0_prep(a, lds); } SEAM(0);
    if (IN(1)) { rows_phase<false>(a.in[I_X], (bf16*)a.out, nullptr, a.in[I_NORMG], mod + 1024, mod); } SEAM(1);
    if (IN(2)) { pg8::Gemm g{(const bf16*)a.out, (const bf16*)(ws + WS_WIN), S, EIN, D, D, D, 30, 0}; pg8::StaticOrder so; so.init(S, EIN, G, (int)blockIdx.x);
        pg8::EpiBf16P E{(bf16*)(ws + WS_PROJ0), EIN}; pg8::gemm_phase<pg8::EpiBf16P, pg8::StaticOrder, true, true>(lds, g, so, E); } SEAM(2);
    if (IN(3)) { lru_phase<false>(a, lds); } SEAM(3);
    if (IN(4)) { lru_phase<true>(a, lds); } SEAM(4);
    if (IN(5)) { pg8::Gemm g{(const bf16*)(ws + WS_PROJ0) + 1024, (const bf16*)(ws + WS_WOUT), S, D, 2048, EIN, 2048, 30, 0}; pg8::StaticOrder so; so.init(S, D, G, (int)blockIdx.x);
        pg8::EpiResGate E{a.in[I_X], a.out, mod + 2048, D}; pg8::gemm_phase<pg8::EpiResGate, pg8::StaticOrder, true, true>(lds, g, so, E); } SEAM(5);
    if (IN(6)) { rows_phase<false>(a.out, (bf16*)(ws + WS_H1), nullptr, a.in[I_NORMG] + D, mod + 3072 + 1024, mod + 3072); } SEAM(6);
    if (IN(7)) { pg8::Gemm g{(const bf16*)(ws + WS_H1), (const bf16*)(ws + WS_PWIN), S, 4096, D, D, D, 30, 0}; pg8::StaticOrder so; so.init(S, 4096, G, (int)blockIdx.x);
        pg8::EpiBf16P E{(bf16*)(ws + WS_PROJ1), 4096}; pg8::gemm_phase<pg8::EpiBf16P, pg8::StaticOrder, true, true>(lds, g, so, E); } SEAM(7);
    if (IN(8)) { pool_phase(a); } SEAM(8);
    if (IN(9)) { pg8::Gemm g{(const bf16*)(ws + WS_DP), (const bf16*)(ws + WS_PGRP), S, PW, 512, PW, 512, 1, 1024}; pg8::StaticOrder so; so.init(S, PW, G, (int)blockIdx.x);
        pg8::EpiGrp E{(bf16*)(ws + WS_PROJ1) + 2048, 4096, a.in[I_PBGRP], a.in[I_PSCALE]}; pg8::gemm_phase<pg8::EpiGrp, pg8::StaticOrder, true, true>(lds, g, so, E); } SEAM(9);
    if (IN(10)) { pg8::Gemm g{(const bf16*)(ws + WS_PROJ1) + 2048, (const bf16*)(ws + WS_PWOUT), S, D, 2048, 4096, 2048, 30, 0}; pg8::StaticOrder so; so.init(S, D, G, (int)blockIdx.x);
        pg8::EpiResGate E{a.out, a.out, mod + 3072 + 2048, D}; pg8::gemm_phase<pg8::EpiResGate, pg8::StaticOrder, true, true>(lds, g, so, E); } SEAM(10);
    if (IN(11)) { rows_phase<true>(a.out, nullptr, a.out, a.in[I_FINALG], nullptr, nullptr); }
#undef IN
#undef SEAM
}

extern "C" void kernel_launch(void* const* d_in, const int* in_sizes, int n_in, void* d_out, int out_size, void* d_ws, size_t ws_size, hipStream_t stream) {
    static int grid = 0;
    if (grid == 0) {
        if (n_in != 21 || out_size != S * D || ws_size < 256 * MiB) { fprintf(stderr, "kernel_launch: unexpected shapes (n_in %d out %d ws %zu)\n", n_in, out_size, ws_size); grid = -1; return; }
        int dev = 0, cus = 0, per_cu = 0;
        hipGetDevice(&dev); hipDeviceGetAttribute(&cus, hipDeviceAttributeMultiprocessorCount, dev);
        if (hipFuncSetAttribute((const void*)mk_fwd, hipFuncAttributeMaxDynamicSharedMemorySize, LDS_BYTES) != hipSuccess) { fprintf(stderr, "kernel_launch: hipFuncSetAttribute failed\n"); grid = -1; return; }
        if (hipOccupancyMaxActiveBlocksPerMultiprocessor(&per_cu, (const void*)mk_fwd, 512, LDS_BYTES) != hipSuccess || per_cu < 1) { fprintf(stderr, "kernel_launch: occupancy query says %d\n", per_cu); per_cu = 1; }
        (void)hipGetLastError();
        grid = cus * per_cu; if (grid > 256) grid = 256;
        fprintf(stderr, "kernel_launch: grid %d (cus %d per_cu %d)\n", grid, cus, per_cu);
    }
    if (grid < 0) return;
    Args a{};
    for (int i = 0; i < 21; ++i) a.in[i] = (const float*)d_in[i];
    a.out = (float*)d_out; a.ws = (unsigned char*)d_ws;
#if MK_N_LAUNCHES == 1
    a.ph_lo = 0; a.ph_hi = NPH;
    { void* args[] = {&a}; hipError_t e = hipLaunchCooperativeKernel((const void*)mk_fwd, dim3(grid), dim3(512), args, LDS_BYTES, stream);
      if (e != hipSuccess) fprintf(stderr, "kernel_launch: cooperative launch failed: %s (grid %d)\n", hipGetErrorString(e), grid); }
#else
    for (int ph = 0; ph < NPH; ++ph) { a.ph_lo = ph; a.ph_hi = ph + 1; hipLaunchKernelGGL(mk_fwd, dim3(grid), dim3(512), LDS_BYTES, stream, a); }
#endif
}
```

```cpp
#include <hip/hip_runtime.h>
#include <hip/hip_cooperative_groups.h>
#include <cstdio>
#include <cstdint>
namespace cg = cooperative_groups;
#ifndef DUPMASK
#define DUPMASK 0
#endif
#ifndef EXTRA_SYNCS
#define EXTRA_SYNCS 0
#endif
#ifndef PROBE_P4
#define PROBE_P4 0
#endif
#ifndef PROBE_P9
#define PROBE_P9 0
#endif
#ifndef MK_N_LAUNCHES
#define MK_N_LAUNCHES 1
#endif
namespace pg8 {
#define PG8_LAS __attribute__((address_space(3)))
typedef unsigned short bf16_t;
typedef short bf16x8 __attribute__((ext_vector_type(8)));
typedef float f32x4 __attribute__((ext_vector_type(4)));
typedef unsigned u32x4 __attribute__((ext_vector_type(4)));
constexpr int BM = 256, BK = 64, HALF = 128, HTB = HALF * BK * 2  , STAGE_BYTES = 8 * HTB, NXCD = 8, WGM = 8;

__host__ __device__ __forceinline__ int lds_byte(int r, int c) { const int st = (r >> 4) * 2 + (c >> 5), rr = r & 15, cc = c & 31, ob = rr * 64 + cc * 2; return st * 1024 + (ob ^ (((ob >> 9) & 1) << 5)); }
__host__ __device__ __forceinline__ void stage_rc(int b, int& R, int& C) { const int st = b / 1024, sb = b % 1024, swz = sb ^ (((sb >> 9) & 1) << 5); R = (st >> 1) * 16 + swz / 64; C = (st & 1) * 32 + (swz % 64) / 2; }
__host__ __device__ __forceinline__ int perm32(int rho) { const int n = rho >> 4, i = rho & 15; return 8 * (i >> 2) + 4 * n + (i & 3); }

struct Unit { int pm, pn; };
struct Gemm { const bf16_t* A; const bf16_t* Bt; int M, N, K, lda, ldb, a_pn_shift, a_pn_bytes; };

struct StaticOrder {
    int nM, nN, nwg, G, c;
    __host__ __device__ void init(int M, int N, int G_, int c_) { nM = M / BM; nN = N / BM; nwg = nM * nN; G = G_; c = c_; }
    __host__ __device__ bool next(int i, Unit& u) const {
        const long L = (long)i * G + c; if (L >= nwg) return false;
        int wgid = (int)L; { const int q = nwg / NXCD, r = nwg % NXCD, xcd = wgid % NXCD, off = wgid / NXCD; wgid = (xcd < r ? xcd * (q + 1) : r * (q + 1) + (xcd - r) * q) + off; }
        const int nig = WGM * nN, gid = wgid / nig, fm = gid * WGM, gsz = (nM - fm) < WGM ? (nM - fm) : WGM;
        u.pm = fm + ((wgid % nig) % gsz); u.pn = (wgid % nig) / gsz; return true;
    }
    __device__ __forceinline__ void a_ready(const Unit&) const {}
    __device__ __forceinline__ void done(const Unit&) const {}
};
__device__ __forceinline__ unsigned cvt_pk_bf16(float lo, float hi) { unsigned r; asm volatile("v_cvt_pk_bf16_f32 %0, %1, %2" : "=v"(r) : "v"(lo), "v"(hi)); return r; }
}
namespace pg8 {
struct EpiBf16P {
    static constexpr bool PERM = true, AFTER_DRAIN = false;
    bf16_t* O; int ldc;
    __device__ __forceinline__ void operator()(const f32x4 (&acc)[2][2][4][2], const Unit& u, int wr, int wc, int fr, int fq) const {
        const int row0 = u.pm * BM + wr * 64 + fr, col0 = u.pn * BM + wc * 32 + 8 * fq;
#pragma unroll
        for (int ai = 0; ai < 2; ++ai)
#pragma unroll
            for (int m = 0; m < 4; ++m) { bf16_t* rowp = O + (size_t)(row0 + ai * HALF + m * 16) * ldc + col0;
#pragma unroll
                for (int bj = 0; bj < 2; ++bj) { const f32x4 v0 = acc[ai][bj][m][0], v1 = acc[ai][bj][m][1];
                    u32x4 w; w.x = cvt_pk_bf16(v0[0], v0[1]); w.y = cvt_pk_bf16(v0[2], v0[3]); w.z = cvt_pk_bf16(v1[0], v1[1]); w.w = cvt_pk_bf16(v1[2], v1[3]);
                    *(u32x4*)(rowp + bj * HALF) = w; } }
    }
};
struct EpiResGate {
    static constexpr bool PERM = false, AFTER_DRAIN = false;
    const float* base; float* out; const float* gate; int ldc;
    __device__ __forceinline__ void operator()(const f32x4 (&acc)[2][2][4][2], const Unit& u, int wr, int wc, int fr, int fq) const {
        const int row0 = u.pm * BM + wr * 64 + fr, col0 = u.pn * BM + wc * 32 + 4 * fq;
        f32x4 gv[2][2];
#pragma unroll
        for (int bj = 0; bj < 2; ++bj)
#pragma unroll
            for (int n = 0; n < 2; ++n) gv[bj][n] = *(const f32x4*)(gate + col0 + bj * HALF + n * 16);
#pragma unroll
        for (int ai = 0; ai < 2; ++ai)
#pragma unroll
            for (int m = 0; m < 4; ++m) { const size_t off = (size_t)(row0 + ai * HALF + m * 16) * ldc + col0;
#pragma unroll
                for (int bj = 0; bj < 2; ++bj)
#pragma unroll
                    for (int n = 0; n < 2; ++n) { const f32x4 bs = *(const f32x4*)(base + off + bj * HALF + n * 16); *(f32x4*)(out + off + bj * HALF + n * 16) = bs + gv[bj][n] * acc[ai][bj][m][n]; }
                asm volatile("" ::: "memory"); }
    }
};
struct EpiGrp {
    static constexpr bool PERM = true, AFTER_DRAIN = false;
    bf16_t* G; int ldc; const float* bias; const float* scale; bf16_t* probe;
    __device__ __forceinline__ void operator()(const f32x4 (&acc)[2][2][4][2], const Unit& u, int wr, int wc, int fr, int fq) const {
        const int row0 = u.pm * BM + wr * 64 + fr, col0 = u.pn * BM + wc * 32 + 8 * fq;
        f32x4 bv[2][2], sv[2][2];
#pragma unroll
        for (int bj = 0; bj < 2; ++bj)
#pragma unroll
            for (int n = 0; n < 2; ++n) { bv[bj][n] = *(const f32x4*)(bias + col0 + bj * HALF + 4 * n); sv[bj][n] = *(const f32x4*)(scale + col0 + bj * HALF + 4 * n); }
#pragma unroll
        for (int ai = 0; ai < 2; ++ai)
#pragma unroll
            for (int m = 0; m < 4; ++m) { bf16_t* rowp = G + (size_t)(row0 + ai * HALF + m * 16) * ldc + col0;
#pragma unroll
                for (int bj = 0; bj < 2; ++bj) { const u32x4 gw = *(const u32x4*)(rowp + bj * HALF);
                    const float g0 = __uint_as_float(gw.x << 16), g1 = __uint_as_float(gw.x & 0xffff0000u), g2 = __uint_as_float(gw.y << 16), g3 = __uint_as_float(gw.y & 0xffff0000u);
                    const float g4 = __uint_as_float(gw.z << 16), g5 = __uint_as_float(gw.z & 0xffff0000u), g6 = __uint_as_float(gw.w << 16), g7 = __uint_as_float(gw.w & 0xffff0000u);
                    const f32x4 s0 = (f32x4){g0, g1, g2, g3}, s1 = (f32x4){g4, g5, g6, g7};
                    f32x4 e0, e1;
#pragma unroll
                    for (int j = 0; j < 4; ++j) { e0[j] = s0[j] * __builtin_amdgcn_rcpf(1.0f + __builtin_amdgcn_exp2f(-s0[j] * 1.4426950408889634f)); e1[j] = s1[j] * __builtin_amdgcn_rcpf(1.0f + __builtin_amdgcn_exp2f(-s1[j] * 1.4426950408889634f)); }
                    const f32x4 v0 = (acc[ai][bj][m][0] + bv[bj][0]) * sv[bj][0] * e0, v1 = (acc[ai][bj][m][1] + bv[bj][1]) * sv[bj][1] * e1;
                    u32x4 w; w.x = cvt_pk_bf16(v0[0], v0[1]); w.y = cvt_pk_bf16(v0[2], v0[3]); w.z = cvt_pk_bf16(v1[0], v1[1]); w.w = cvt_pk_bf16(v1[2], v1[3]);
                    if (probe) *(u32x4*)(probe + (size_t)(row0 + ai * HALF + m * 16) * 1024 + ((col0 + bj * HALF) & 1023)) = w; else *(u32x4*)(rowp + bj * HALF) = w; } }
    }
};
template <class Epi, class Sched, bool ALIGN_EPI = false, bool SP2 = false>
__device__ __forceinline__ void gemm_phase(PG8_LAS unsigned char* lds, const Gemm g, const Sched& S, const Epi& E) {
    const int tid = threadIdx.x, wid = __builtin_amdgcn_readfirstlane(tid >> 6), lane = tid & 63, wr = wid >> 2, wc = wid & 3, fr = lane & 15, fq = lane >> 4;
    const int K = g.K, nt = K / BK, lda = g.lda, ldb = g.ldb;
    unsigned voffA[2], voffB[2];
#pragma unroll
    for (int i = 0; i < 2; ++i) { int R, C; stage_rc(tid * 16 + i * 8192, R, C); const int Rb = Epi::PERM ? ((R & ~31) + perm32(R & 31)) : R;
        voffA[i] = (unsigned)(R * lda + C) * 2u; voffB[i] = (unsigned)(Rb * ldb + C) * 2u; }
    const size_t kstep = (size_t)(BK * 2);
    const size_t hstepA = (size_t)HALF * lda * 2, hstepB = (size_t)HALF * ldb * 2;
    const size_t tstepA = 2 * hstepA, tstepB = 2 * hstepB;
    const unsigned ldsw = (unsigned)wid * 1024u;
    const int aoff = lds_byte(wr * 64 + fr, fq * 8), boff = lds_byte(wc * 32 + fr, fq * 8);
#define PG8_SA(b, h) (((b) * 2 + (h)) * HTB)
#define PG8_SB(b, h) ((4 + (b) * 2 + (h)) * HTB)
#define PG8_STAGE(bufoff, gbase, voff) do { _Pragma("unroll") for (int _i = 0; _i < 2; ++_i) \
        __builtin_amdgcn_global_load_lds((const unsigned*)((const char*)(gbase) + (voff)[_i]), (PG8_LAS unsigned*)(lds + (bufoff) + ldsw + _i * 8192), 16, 0, 0); } while (0)
#define PG8_LDA(dst, b, h) do { _Pragma("unroll") for (int m = 0; m < 4; ++m) _Pragma("unroll") for (int k = 0; k < 2; ++k) dst[m][k] = *(const PG8_LAS bf16x8*)(lds + PG8_SA(b, h) + aoff + m * 2048 + k * 1024); } while (0)
#define PG8_LDB(dst, b, h) do { _Pragma("unroll") for (int n = 0; n < 2; ++n) _Pragma("unroll") for (int k = 0; k < 2; ++k) dst[n][k] = *(const PG8_LAS bf16x8*)(lds + PG8_SB(b, h) + boff + n * 2048 + k * 1024); } while (0)
#define PG8_MMA(ai, bj, At, Bt) do { __builtin_amdgcn_s_setprio(1); _Pragma("unroll") for (int m = 0; m < 4; ++m) _Pragma("unroll") for (int n = 0; n < 2; ++n) _Pragma("unroll") for (int k = 0; k < 2; ++k) \
        acc[ai][bj][m][n] = __builtin_amdgcn_mfma_f32_16x16x32_bf16(Bt[n][k], At[m][k], acc[ai][bj][m][n], 0, 0, 0); __builtin_amdgcn_s_setprio(0); } while (0)
#define PG8_WAIT_V(n) asm volatile("s_waitcnt vmcnt(" #n ")" ::: "memory")
#define PG8_WAIT_L(n) asm volatile("s_waitcnt lgkmcnt(" #n ")" ::: "memory")
#define PG8_BAR __builtin_amdgcn_s_barrier()
#define PG8_SCHED __builtin_amdgcn_sched_barrier(0)
    Unit cur, nxt; int ui = 0;
    if (!S.next(0, cur)) return;
    f32x4 acc[2][2][4][2];
#pragma unroll
    for (int a = 0; a < 2; ++a)
#pragma unroll
        for (int b = 0; b < 2; ++b)
#pragma unroll
            for (int m = 0; m < 4; ++m)
#pragma unroll
                for (int n = 0; n < 2; ++n) acc[a][b][m][n] = (f32x4){0.f, 0.f, 0.f, 0.f};
    bf16x8 At[4][2], B0[2][2], B1[2][2];
    const char* cA = (const char*)g.A + (size_t)cur.pm * tstepA + (size_t)(cur.pn >> g.a_pn_shift) * g.a_pn_bytes; const char* cB = (const char*)g.Bt + (size_t)cur.pn * tstepB;
    S.a_ready(cur);
    if constexpr (SP2) {
        PG8_STAGE(PG8_SB(0, 0), cB, voffB); PG8_STAGE(PG8_SB(0, 1), cB + hstepB, voffB); PG8_STAGE(PG8_SA(0, 0), cA, voffA); PG8_STAGE(PG8_SA(0, 1), cA + hstepA, voffA);
        if (wr == 1) PG8_BAR;
        PG8_WAIT_V(2); PG8_BAR;
        PG8_STAGE(PG8_SB(1, 0), cB + kstep, voffB); PG8_STAGE(PG8_SA(1, 0), cA + kstep, voffA); PG8_STAGE(PG8_SB(1, 1), cB + hstepB + kstep, voffB);
        PG8_WAIT_V(6); PG8_BAR;
    } else {
        PG8_STAGE(PG8_SB(0, 0), cB, voffB); PG8_STAGE(PG8_SA(0, 0), cA, voffA); PG8_STAGE(PG8_SB(0, 1), cB + hstepB, voffB); PG8_STAGE(PG8_SA(0, 1), cA + hstepA, voffA);
        if (wr == 1) PG8_BAR;
        PG8_WAIT_V(4); PG8_BAR;
        PG8_STAGE(PG8_SB(1, 0), cB + kstep, voffB); PG8_STAGE(PG8_SA(1, 0), cA + kstep, voffA); PG8_STAGE(PG8_SB(1, 1), cB + hstepB + kstep, voffB);
        PG8_WAIT_V(6); PG8_BAR;
    }
    for (;;) {
        const bool has_next = S.next(ui + 1, nxt);
        const char* nA = has_next ? (const char*)g.A + (size_t)nxt.pm * tstepA + (size_t)(nxt.pn >> g.a_pn_shift) * g.a_pn_bytes : cA; const char* nB = has_next ? (const char*)g.Bt + (size_t)nxt.pn * tstepB : cB;
        for (int t = 0; t < nt; t += 2) {
            const bool last = (t == nt - 2);
            const char* a1 = cA + (size_t)(t + 1) * kstep;
            const char* a2 = last ? nA : cA + (size_t)(t + 2) * kstep; const char* b2 = last ? nB : cB + (size_t)(t + 2) * kstep;
            const char* a3 = a2 + kstep; const char* b3 = b2 + kstep;
            if (last && has_next) S.a_ready(nxt);
            if constexpr (SP2) {
            PG8_LDB(B0, 0, 0); PG8_LDB(B1, 0, 1); PG8_SCHED; PG8_LDA(At, 0, 0); PG8_STAGE(PG8_SA(1, 1), a1 + hstepA, voffA);
            PG8_WAIT_V(8); PG8_WAIT_L(0); PG8_BAR; PG8_MMA(0, 0, At, B0); PG8_MMA(0, 1, At, B1); PG8_BAR; PG8_SCHED;
            PG8_LDA(At, 0, 1); PG8_STAGE(PG8_SB(0, 0), b2, voffB); PG8_STAGE(PG8_SB(0, 1), b2 + hstepB, voffB); PG8_STAGE(PG8_SA(0, 0), a2, voffA);
            PG8_WAIT_V(8); PG8_WAIT_L(0); PG8_BAR; PG8_MMA(1, 0, At, B0); PG8_MMA(1, 1, At, B1); PG8_BAR; PG8_SCHED;
            PG8_LDB(B0, 1, 0); PG8_LDB(B1, 1, 1); PG8_SCHED; PG8_LDA(At, 1, 0); PG8_STAGE(PG8_SA(0, 1), a2 + hstepA, voffA);
            PG8_WAIT_V(8); PG8_WAIT_L(0); PG8_BAR; PG8_MMA(0, 0, At, B0); PG8_MMA(0, 1, At, B1); PG8_BAR; PG8_SCHED;
            PG8_LDA(At, 1, 1); PG8_STAGE(PG8_SB(1, 0), b3, voffB); PG8_STAGE(PG8_SB(1, 1), b3 + hstepB, voffB); PG8_STAGE(PG8_SA(1, 0), a3, voffA);
            PG8_WAIT_V(8); PG8_WAIT_L(0); PG8_BAR; PG8_MMA(1, 0, At, B0); PG8_MMA(1, 1, At, B1); PG8_BAR; PG8_SCHED;
            } else {
            PG8_LDB(B0, 0, 0); PG8_SCHED; PG8_LDA(At, 0, 0); PG8_STAGE(PG8_SA(1, 1), a1 + hstepA, voffA);
            PG8_WAIT_L(8); PG8_BAR; PG8_WAIT_L(0); PG8_MMA(0, 0, At, B0); PG8_BAR; PG8_SCHED;
            PG8_LDB(B1, 0, 1); PG8_STAGE(PG8_SB(0, 0), b2, voffB);
            PG8_BAR; PG8_WAIT_L(0); PG8_MMA(0, 1, At, B1); PG8_BAR;
            PG8_LDA(At, 0, 1); PG8_STAGE(PG8_SA(0, 0), a2, voffA);
            PG8_BAR; PG8_WAIT_L(0); PG8_MMA(1, 0, At, B0); PG8_BAR; PG8_SCHED;
            PG8_STAGE(PG8_SB(0, 1), b2 + hstepB, voffB);
            PG8_WAIT_V(6); PG8_BAR; PG8_MMA(1, 1, At, B1); PG8_BAR;
            PG8_LDB(B0, 1, 0); PG8_SCHED; PG8_LDA(At, 1, 0); PG8_STAGE(PG8_SA(0, 1), a2 + hstepA, voffA);
            PG8_WAIT_L(8); PG8_BAR; PG8_WAIT_L(0); PG8_MMA(0, 0, At, B0); PG8_BAR; PG8_SCHED;
            PG8_LDB(B1, 1, 1); PG8_STAGE(PG8_SB(1, 0), b3, voffB);
            PG8_BAR; PG8_WAIT_L(0); PG8_MMA(0, 1, At, B1); PG8_BAR;
            PG8_LDA(At, 1, 1); PG8_STAGE(PG8_SA(1, 0), a3, voffA);
            PG8_BAR; PG8_WAIT_L(0); PG8_MMA(1, 0, At, B0); PG8_BAR; PG8_SCHED;
            PG8_STAGE(PG8_SB(1, 1), b3 + hstepB, voffB);
            PG8_WAIT_V(6); PG8_BAR; PG8_MMA(1, 1, At, B1); PG8_BAR;
            }
        }
        if constexpr (ALIGN_EPI) { if (wr == 0) PG8_BAR; }
        if constexpr (!Epi::AFTER_DRAIN) { E(acc, cur, wr, wc, fr, fq); S.done(cur); }
        if (!has_next) break;
#pragma unroll
        for (int a = 0; a < 2; ++a)
#pragma unroll
            for (int b = 0; b < 2; ++b)
#pragma unroll
                for (int m = 0; m < 4; ++m)
#pragma unroll
                    for (int n = 0; n < 2; ++n) acc[a][b][m][n] = (f32x4){0.f, 0.f, 0.f, 0.f};
        cur = nxt; cA = nA; cB = nB; ++ui;
        if constexpr (ALIGN_EPI) { if (wr == 1) PG8_BAR; }
    }
    PG8_WAIT_V(0);
    if constexpr (!ALIGN_EPI) { if (wr == 0) PG8_BAR; }
    PG8_BAR;
    if constexpr (Epi::AFTER_DRAIN) { E.fused(acc, cur, wr, wc, fr, fq, lds, wid, lane); S.done(cur); }
#undef PG8_SA
#undef PG8_SB
#undef PG8_STAGE
#undef PG8_LDA
#undef PG8_LDB
#undef PG8_MMA
#undef PG8_WAIT_V
#undef PG8_WAIT_L
#undef PG8_BAR
#undef PG8_SCHED
}
}
constexpr int S = 16384, D = 1024, EIN = 6144, PW = 2048, NPH = 12;
constexpr float EPS = 1e-6f, LOG2E = 1.4426950408889634f;
constexpr size_t MiB = 1u << 20;
constexpr size_t WS_MOD = 0;
constexpr size_t WS_BAR = 2 * MiB, BAR_ZERO_BYTES = 16384;
constexpr size_t WS_AGG = 1 * MiB;
constexpr size_t WS_WIN = 4 * MiB;
constexpr size_t WS_WOUT = 16 * MiB;
constexpr size_t WS_PWIN = 20 * MiB;
constexpr size_t WS_PGRP = 28 * MiB;
constexpr size_t WS_PWOUT = 30 * MiB;
constexpr size_t WS_LWA = 34 * MiB;
constexpr size_t WS_LWX = 34 * MiB + 512 * 1024;
constexpr size_t WS_PROJ0 = 36 * MiB;
constexpr size_t WS_H1 = 224 * MiB;
constexpr size_t WS_PROJ1 = 36 * MiB;
constexpr size_t WS_DP = 164 * MiB;
constexpr int LDS_BYTES = 147456;

#define LAS __attribute__((address_space(3)))
typedef unsigned short bf16;
typedef float f32x4 __attribute__((ext_vector_type(4)));
typedef unsigned u32x4 __attribute__((ext_vector_type(4)));
typedef unsigned u32x2 __attribute__((ext_vector_type(2)));
typedef short bf16x8 __attribute__((ext_vector_type(8)));
using pg8::cvt_pk_bf16;
__device__ __forceinline__ float bf2f(unsigned short b) { return __uint_as_float(((unsigned)b) << 16); }
__device__ __forceinline__ float bflo(unsigned w) { return __uint_as_float(w << 16); }
__device__ __forceinline__ float bfhi(unsigned w) { return __uint_as_float(w & 0xffff0000u); }
__device__ __forceinline__ unsigned short f2bf(float f) { unsigned u = __float_as_uint(f); return (unsigned short)((u + 0x7fffu + ((u >> 16) & 1u)) >> 16); }
__device__ __forceinline__ float sigmoidf_(float x) { return __builtin_amdgcn_rcpf(1.0f + __builtin_amdgcn_exp2f(-x * LOG2E)); }
__device__ __forceinline__ float siluf_(float x) { return x * sigmoidf_(x); }
__device__ __forceinline__ float wave_sum(float v) {
#pragma unroll
    for (int o = 1; o < 64; o <<= 1) v += __shfl_xor(v, o);
    return v;
}
__device__ __forceinline__ void unpack8(const u32x4 w, float (&f)[8]) { f[0] = bflo(w.x); f[1] = bfhi(w.x); f[2] = bflo(w.y); f[3] = bfhi(w.y); f[4] = bflo(w.z); f[5] = bfhi(w.z); f[6] = bflo(w.w); f[7] = bfhi(w.w); }
__device__ __forceinline__ u32x4 pack8(const float (&f)[8]) { u32x4 w; w.x = cvt_pk_bf16(f[0], f[1]); w.y = cvt_pk_bf16(f[2], f[3]); w.z = cvt_pk_bf16(f[4], f[5]); w.w = cvt_pk_bf16(f[6], f[7]); return w; }

struct Args { const float* in[21]; float* out; unsigned char* ws; int ph_lo, ph_hi; };
enum { I_X = 0, I_C, I_NORMG, I_MODW, I_MODB, I_HYWIN, I_CONVW, I_CONVB, I_LWA, I_LBA, I_LWX, I_LBX, I_LAM, I_SCW, I_HYWOUT, I_PWIN, I_PGRP, I_PBGRP, I_PSCALE, I_PWOUT, I_FINALG };

__device__ __forceinline__ void transpose_item(const float* W, int N, int k0, int n0, bf16* WT, int ldt, int drow0, LAS float* scr, int lane) {
#pragma unroll 8
    for (int i = 0; i < 32; ++i) { const int kk = 2 * i + (lane >> 5); scr[kk * 33 + (lane & 31)] = W[(size_t)(k0 + kk) * N + n0 + (lane & 31)]; }
    asm volatile("s_waitcnt lgkmcnt(0)" ::: "memory");
    const int c = lane & 7;
#pragma unroll
    for (int j = 0; j < 4; ++j) { const int n = (lane >> 3) + 8 * j; const LAS float* s = scr + (8 * c) * 33 + n;
        u32x4 o; o.x = cvt_pk_bf16(s[0 * 33], s[1 * 33]); o.y = cvt_pk_bf16(s[2 * 33], s[3 * 33]); o.z = cvt_pk_bf16(s[4 * 33], s[5 * 33]); o.w = cvt_pk_bf16(s[6 * 33], s[7 * 33]);
        *(u32x4*)(WT + (size_t)(drow0 + n) * ldt + k0 + 8 * c) = o; }
    asm volatile("s_waitcnt lgkmcnt(0)" ::: "memory");
}
__device__ __forceinline__ void p0_prep(const Args& a, LAS unsigned char* lds) {
    const int tid = threadIdx.x, lane = tid & 63, w = __builtin_amdgcn_readfirstlane(tid >> 6);
    unsigned char* ws = a.ws;
    { LAS float* red = (LAS float*)lds; float* mod = (float*)(ws + WS_MOD);
      for (int it = blockIdx.x; it < 96; it += gridDim.x) {
        const int l = it / 48, cgp = it % 48; const float* Wp = a.in[I_MODW] + (size_t)l * D * 3072 + 64 * cgp + lane; const float* cp = a.in[I_C];
        float acc = 0.f;
#pragma unroll 8
        for (int kk = 0; kk < 128; ++kk) { const int k = 128 * w + kk; const float cv = cp[k]; acc += siluf_(cv) * Wp[(size_t)k * 3072]; }
        red[w * 64 + lane] = acc; __syncthreads();
        if (w == 0) { float s = 0.f;
#pragma unroll
            for (int i = 0; i < 8; ++i) s += red[i * 64 + lane];
            mod[l * 3072 + 64 * cgp + lane] = s + a.in[I_MODB][l * 3072 + 64 * cgp + lane]; }
        __syncthreads(); } }
    LAS float* scr = (LAS float*)(lds + w * 16384);
    const int gw = blockIdx.x * 8 + w, NGW = gridDim.x * 8;
    constexpr int I0 = 16 * 192, I1 = 32 * 32, I2 = 16 * 128, I3 = 4 * 128, I4 = 32 * 32, I5 = 16 * 8, NIT = I0 + I1 + I2 + I3 + I4 + I5;
    for (int it = gw; it < NIT; it += NGW) {
        int r = it;
        if (r < I0) { const int kb = r / 192, nb = r % 192, n0 = 32 * nb, sb = n0 >> 10; const int db = (sb == 0) ? 0 : (sb == 1) ? 1 : (sb == 5) ? 2 : sb + 1;
            transpose_item(a.in[I_HYWIN], EIN, 64 * kb, n0, (bf16*)(ws + WS_WIN), D, db * 1024 + (n0 & 1023), scr, lane); continue; } r -= I0;
        if (r < I1) { const int kb = r / 32, nb = r % 32; transpose_item(a.in[I_HYWOUT], D, 64 * kb, 32 * nb, (bf16*)(ws + WS_WOUT), 2048, 32 * nb, scr, lane); continue; } r -= I1;
        if (r < I2) { const int kb = r / 128, nb = r % 128; transpose_item(a.in[I_PWIN], 4096, 64 * kb, 32 * nb, (bf16*)(ws + WS_PWIN), D, 32 * nb, scr, lane); continue; } r -= I2;
        if (r < I3) { const int g = r / 128, q = r % 128, kb = q / 16, nb = q % 16; transpose_item(a.in[I_PGRP] + (size_t)g * 512 * 512, 512, 64 * kb, 32 * nb, (bf16*)(ws + WS_PGRP) + (size_t)g * 512 * 512, 512, 32 * nb, scr, lane); continue; } r -= I3;
        if (r < I4) { const int kb = r / 32, nb = r % 32; transpose_item(a.in[I_PWOUT], D, 64 * kb, 32 * nb, (bf16*)(ws + WS_PWOUT), 2048, 32 * nb, scr, lane); continue; } r -= I4;
        { const int m = r / 8, q = r % 8, kb = q / 4, nb = q % 4; const float* src = (m < 8 ? a.in[I_LWA] : a.in[I_LWX]) + (size_t)(m & 7) * 128 * 128;
          bf16* dst = (bf16*)(ws + (m < 8 ? WS_LWA : WS_LWX)) + (size_t)(m & 7) * 128 * 128; transpose_item(src, 128, 64 * kb, 32 * nb, dst, 128, 32 * nb, scr, lane); }
    }
}

template <bool FINAL>
__device__ __forceinline__ void rows_phase(const float* X, bf16* H, float* OUT, const float* g, const float* scale, const float* shift) {
    const int tid = threadIdx.x, lane = tid & 63, w = tid >> 6; const int gw = blockIdx.x * 8 + w, NGW = gridDim.x * 8;
    f32x4 gs[4], sh[4];
#pragma unroll
    for (int j = 0; j < 4; ++j) { const int col = 4 * lane + 256 * j; gs[j] = *(const f32x4*)(g + col);
        if (!FINAL) { gs[j] = gs[j] * (*(const f32x4*)(scale + col) + 1.0f); sh[j] = *(const f32x4*)(shift + col); } else sh[j] = (f32x4){0.f, 0.f, 0.f, 0.f}; }
    for (int m = gw; m < S; m += NGW) {
        const f32x4* xr = (const f32x4*)(X + (size_t)m * D) + lane; f32x4 v[4]; float s = 0.f;
#pragma unroll
        for (int j = 0; j < 4; ++j) { v[j] = xr[64 * j]; s += (v[j].x * v[j].x + v[j].y * v[j].y) + (v[j].z * v[j].z + v[j].w * v[j].w); }
        const float rstd = 1.0f / sqrtf(wave_sum(s) * (1.0f / D) + EPS);
        if (FINAL) { f32x4* o = (f32x4*)(OUT + (size_t)m * D) + lane;
#pragma unroll
            for (int j = 0; j < 4; ++j) o[64 * j] = v[j] * rstd * gs[j]; }
        else { u32x2* o = (u32x2*)(H + (size_t)m * D) + lane;
#pragma unroll
            for (int j = 0; j < 4; ++j) { const f32x4 y = v[j] * rstd * gs[j] + sh[j]; u32x2 pk; pk.x = cvt_pk_bf16(y.x, y.y); pk.y = cvt_pk_bf16(y.z, y.w); o[64 * j] = pk; } }
    }
}
template <bool FINAL, bool PROBE = false>
__device__ __forceinline__ void lru_phase(const Args& a, LAS unsigned char* lds) {
    const int tid = threadIdx.x, lane = tid & 63, w = __builtin_amdgcn_readfirstlane(tid >> 6), fr = lane & 15, fq = lane >> 4;
    LAS bf16* Abf = (LAS bf16*)lds;
    LAS float* xcT = (LAS float*)(lds + 17408);
    LAS float* hbuf = (LAS float*)(lds + 17408 + 34816);
    bf16* proj0 = (bf16*)(a.ws + WS_PROJ0);
    const bf16* wa_t = (const bf16*)(a.ws + WS_LWA); const bf16* wx_t = (const bf16*)(a.ws + WS_LWX);
    float* agg = (float*)(a.ws + WS_AGG);
    for (int item = blockIdx.x; item < 256; item += gridDim.x) {
        const int hd = item & 7, sc = item >> 3;
        const int cc = tid & 127, q = tid >> 7, gch = hd * 128 + cc;
        const float cw0 = a.in[I_CONVW][gch], cw1 = a.in[I_CONVW][1024 + gch], cw2 = a.in[I_CONVW][2048 + gch], cw3 = a.in[I_CONVW][3072 + gch], cb = a.in[I_CONVB][gch];
        const int ch = hd * 128 + 16 * w + fr;
        const float ba = a.in[I_LBA][ch], bx = a.in[I_LBX][ch];
        const float k8 = -8.0f * log1pf(expf(-a.in[I_LAM][ch])) * LOG2E;
        bf16x8 wa[4], wx[4];
#pragma unroll
        for (int kk = 0; kk < 4; ++kk) { wa[kk] = *(const bf16x8*)(wa_t + (size_t)(hd * 128 + 16 * w + fr) * 128 + 32 * kk + 8 * fq); wx[kk] = *(const bf16x8*)(wx_t + (size_t)(hd * 128 + 16 * w + fr) * 128 + 32 * kk + 8 * fq); }
        float hin = 0.f, Atot = 1.f;
        if (FINAL) { for (int s = 0; s < sc; ++s) { const float2 ab = *(const float2*)(agg + ((size_t)s * 1024 + ch) * 2); hin = ab.x * hin + ab.y; } }
        for (int st = 0; st < 8; ++st) {
            const int t0 = sc * 512 + st * 64;
            { const int tb = t0 + 16 * q; const bf16* xp = proj0 + (size_t)tb * EIN + gch;
              float x0 = 0.f, x1 = 0.f, x2 = 0.f;
              if (tb > 0) { x0 = bf2f(xp[-3 * EIN]); x1 = bf2f(xp[-2 * EIN]); x2 = bf2f(xp[-1 * EIN]); }
              f32x4 v;
#pragma unroll
              for (int i = 0; i < 16; ++i) { const float x3 = bf2f(xp[(size_t)i * EIN]); const float xc = cw0 * x0 + cw1 * x1 + cw2 * x2 + cw3 * x3 + cb;
                  Abf[(16 * q + i) * 136 + cc] = f2bf(xc); v[i & 3] = xc; if ((i & 3) == 3) *(LAS f32x4*)(xcT + cc * 68 + 16 * q + i - 3) = v;
                  x0 = x1; x1 = x2; x2 = x3; } }
            __syncthreads();
#pragma unroll 1
            for (int mb = 0; mb < 4; ++mb) {
                f32x4 ar = (f32x4){0.f, 0.f, 0.f, 0.f}, ai = (f32x4){0.f, 0.f, 0.f, 0.f};
#pragma unroll
                for (int kk = 0; kk < 4; ++kk) { const bf16x8 af = *(const LAS bf16x8*)(Abf + (16 * mb + fr) * 136 + 32 * kk + 8 * fq);
                    ar = __builtin_amdgcn_mfma_f32_16x16x32_bf16(af, wa[kk], ar, 0, 0, 0); ai = __builtin_amdgcn_mfma_f32_16x16x32_bf16(af, wx[kk], ai, 0, 0, 0); }
                const f32x4 xcv = *(const LAS f32x4*)(xcT + (16 * w + fr) * 68 + 16 * mb + 4 * fq);
                float P[4], H[4];
#pragma unroll
                for (int j = 0; j < 4; ++j) { const float r = sigmoidf_(ar[j] + ba), ig = sigmoidf_(ai[j] + bx); const float av = __builtin_amdgcn_exp2f(r * k8);
                    float mult = sqrtf(fmaxf(1.0f - av * av, 0.f)); if (t0 + 16 * mb + 4 * fq + j == 0) mult = 1.0f;
                    const float uv = mult * ig * xcv[j];
                    if (j == 0) { P[0] = av; H[0] = uv; } else { P[j] = P[j - 1] * av; H[j] = av * H[j - 1] + uv; } }
                float A = P[3], B = H[3];
                float A1 = __shfl_up(A, 16), B1 = __shfl_up(B, 16); if (fq >= 1) { B = A * B1 + B; A = A * A1; }
                A1 = __shfl_up(A, 32); B1 = __shfl_up(B, 32); if (fq >= 2) { B = A * B1 + B; A = A * A1; }
                float Ae = __shfl_up(A, 16), Be = __shfl_up(B, 16); if (fq == 0) { Ae = 1.f; Be = 0.f; }
                const float hs = Ae * hin + Be;
                const float At = __shfl(A, 48 + fr), Bt = __shfl(B, 48 + fr);
                if (FINAL) {
#pragma unroll
                    for (int j = 0; j < 4; ++j) hbuf[(16 * mb + 4 * fq + j) * 132 + 16 * w + fr] = P[j] * hs + H[j]; }
                hin = At * hin + Bt; Atot *= At;
            }
            __syncthreads();
            if (FINAL) {
#pragma unroll 1
                for (int rep = 0; rep < 2; ++rep) { const int id = tid + 512 * rep, t = id >> 4, s = id & 15; const int tg = t0 + t; const int c8 = hd * 128 + 8 * s;
                    bf16* rowp = proj0 + (size_t)tg * EIN + c8;
                    const f32x4 h0 = *(const LAS f32x4*)(hbuf + t * 132 + 8 * s), h1 = *(const LAS f32x4*)(hbuf + t * 132 + 8 * s + 4);
                    float gaf[8], o[8]; unpack8(*(const u32x4*)(rowp + 1024), gaf);
#pragma unroll
                    for (int e = 0; e < 4; ++e) { o[e] = h0[e] * siluf_(gaf[e]); o[4 + e] = h1[e] * siluf_(gaf[4 + e]); }
                    if (PROBE) *(u32x4*)((bf16*)a.out + (size_t)S * D + (size_t)tg * D + c8) = pack8(o); else *(u32x4*)(rowp + 1024) = pack8(o);
                    float gbf[8], gpf[8], c0[8], c1[8], c2[8], vv[8], cv[8];
                    unpack8(*(const u32x4*)(rowp + 2048), gbf); unpack8(*(const u32x4*)(rowp + 3072), gpf);
                    unpack8(*(const u32x4*)(rowp + 4096), c2); unpack8(*(const u32x4*)(rowp + 5120), vv);
#pragma unroll
                    for (int e = 0; e < 8; ++e) cv[e] = a.in[I_SCW][2048 + c8 + e] * (c2[e] * vv[e]);
                    if (tg >= 1) { unpack8(*(const u32x4*)(rowp - EIN + 4096), c1); unpack8(*(const u32x4*)(rowp - EIN + 5120), vv);
#pragma unroll
                        for (int e = 0; e < 8; ++e) cv[e] += a.in[I_SCW][1024 + c8 + e] * (c1[e] * vv[e]); }
                    if (tg >= 2) { unpack8(*(const u32x4*)(rowp - 2 * EIN + 4096), c0); unpack8(*(const u32x4*)(rowp - 2 * EIN + 5120), vv);
#pragma unroll
                        for (int e = 0; e < 8; ++e) cv[e] += a.in[I_SCW][c8 + e] * (c0[e] * vv[e]); }
#pragma unroll
                    for (int e = 0; e < 8; ++e) o[e] = gpf[e] * cv[e] * siluf_(gbf[e]);
                    if (PROBE) *(u32x4*)((bf16*)a.out + (size_t)S * D + (size_t)tg * D + c8) = pack8(o); else *(u32x4*)(rowp + 2048) = pack8(o);
                }
            }
        }
        if (!FINAL && fq == 0) *(float2*)(agg + ((size_t)sc * 1024 + ch) * 2) = make_float2(Atot, hin);
    }
}

__device__ __forceinline__ void pool_phase(const Args& a) {
    const bf16* proj1 = (const bf16*)(a.ws + WS_PROJ1); bf16* dp = (bf16*)(a.ws + WS_DP);
    for (int task = blockIdx.x * 512 + threadIdx.x; task < 256 * 512; task += gridDim.x * 512) {
        const int strip = task & 255, run = task >> 8, col = 8 * strip, W = 2 << (col >> 9), t0 = run * 32;
        float sum[8], cur[8], old[8];
#pragma unroll
        for (int e = 0; e < 8; ++e) sum[e] = 0.f;
        for (int i = 1; i <= W; ++i) { const int t = t0 - i; if (t >= 0) { unpack8(*(const u32x4*)(proj1 + (size_t)t * 4096 + col), cur);
#pragma unroll
            for (int e = 0; e < 8; ++e) sum[e] += cur[e]; } }
#pragma unroll 4
        for (int i = 0; i < 32; ++i) { const int t = t0 + i; unpack8(*(const u32x4*)(proj1 + (size_t)t * 4096 + col), cur);
#pragma unroll
            for (int e = 0; e < 8; ++e) sum[e] += cur[e];
            if (t - W >= 0) { unpack8(*(const u32x4*)(proj1 + (size_t)(t - W) * 4096 + col), old);
#pragma unroll
                for (int e = 0; e < 8; ++e) sum[e] -= old[e]; }
            const int cnt = (t + 1 < W) ? t + 1 : W; const float inv = 1.0f / (float)cnt; float o[8];
#pragma unroll
            for (int e = 0; e < 8; ++e) o[e] = sum[e] * inv - cur[e];
            *(u32x4*)(dp + (size_t)t * 2048 + col) = pack8(o); }
    }
}

#define RLX_AGENT __ATOMIC_RELAXED, __HIP_MEMORY_SCOPE_AGENT
#define XB_TMO      128
#define XB_XCNT(j)  (256  + 64 * (j))
#define XB_XSUB(j)  (1280 + 64 * (j))
#define XB_XGEN(j)  (2304 + 64 * (j))
#define XB_TOP      3328
#define XB_TOPGEN   3392
#define XCD_BAR_WORDS 3456
#define XB_SPIN_CAP (1u << 18)

__device__ __forceinline__ unsigned xb_ld(unsigned* p)              { return __hip_atomic_load(p, __ATOMIC_RELAXED, __HIP_MEMORY_SCOPE_AGENT); }
__device__ __forceinline__ unsigned xb_add(unsigned* p, unsigned v) { return __hip_atomic_fetch_add(p, v, __ATOMIC_RELAXED, __HIP_MEMORY_SCOPE_AGENT); }
__device__ __forceinline__ unsigned xb_xcc_id() { return (unsigned)__builtin_amdgcn_s_getreg((3 << 11) | 20) & 0xFu; }
#define XB_SPIN(cond, bar) do { unsigned _sp = 0; while (cond) { __builtin_amdgcn_s_sleep(1); \
    if ((++_sp & 255u) == 0u) { if (xb_ld(&(bar)[XB_TMO])) break; if (_sp > XB_SPIN_CAP) { atomicAdd(&(bar)[XB_TMO], 1u); break; } } } } while (0)

struct XcdBarrier {
    unsigned* bar; unsigned x;
    volatile LAS unsigned* st;
};

__device__ __forceinline__ XcdBarrier xcd_barrier_post(unsigned* bar, volatile LAS unsigned* st) {
    XcdBarrier b; b.bar = bar; b.x = xb_xcc_id(); b.st = st;
    if (threadIdx.x == 0) (void)xb_add(&bar[XB_XCNT(b.x)], 1u);
    return b;
}
__device__ __forceinline__ void xcd_barrier_complete(unsigned* bar, unsigned x, unsigned& nloc, unsigned& nx) {
    const unsigned G = gridDim.x * gridDim.y * gridDim.z;
    unsigned sum, cnt, mine, sp = 0u;
    for (;;) {
        sum = 0u; cnt = 0u; mine = 0u;
#pragma unroll
        for (unsigned j = 0; j < 16; ++j) { const unsigned c = xb_ld(&bar[XB_XCNT(j)]); sum += c; cnt += (c > 0u) ? 1u : 0u; mine = (j == x) ? c : mine; }
        if (sum == G) break;
        __builtin_amdgcn_s_sleep(1);
        if ((++sp & 255u) == 0u) { if (xb_ld(&bar[XB_TMO])) break; if (sp > XB_SPIN_CAP) { atomicAdd(&bar[XB_TMO], 1u); break; } }
    }
    nloc = mine > 0u ? mine : 1u; nx = cnt > 0u ? cnt : 1u;
}

__device__ __forceinline__ void xcd_barrier(const XcdBarrier& b) {
    asm volatile("s_waitcnt vmcnt(0)" ::: "memory");
    __syncthreads();
    if (threadIdx.x == 0) {
        unsigned* bar = b.bar;
        __builtin_amdgcn_s_waitcnt(0);
        unsigned nloc = b.st[0], nx = b.st[1];
        if (nloc == 0u) { xcd_barrier_complete(bar, b.x, nloc, nx); b.st[0] = nloc; b.st[1] = nx; }
        const unsigned old = xb_add(&bar[XB_XSUB(b.x)], 1u);
        const unsigned gen = old / nloc;
        if (old + 1u == (gen + 1u) * nloc) {
            __builtin_amdgcn_fence(__ATOMIC_RELEASE, "agent");
            asm volatile("s_waitcnt vmcnt(0)" ::: "memory");
            const unsigned og = xb_add(&bar[XB_TOP], 1u);
            const unsigned tg = og / nx;
            if (og + 1u == (tg + 1u) * nx) xb_add(&bar[XB_TOPGEN], 1u);
            else XB_SPIN(xb_ld(&bar[XB_TOPGEN]) == tg, bar);
            __builtin_amdgcn_fence(__ATOMIC_ACQUIRE, "agent");
            xb_add(&bar[XB_XGEN(b.x)], 1u);
            asm volatile("s_waitcnt vmcnt(0)" ::: "memory");
        } else {
            XB_SPIN(xb_ld(&bar[XB_XGEN(b.x)]) == gen, bar);
            __builtin_amdgcn_fence(__ATOMIC_ACQUIRE, "agent");
            asm volatile("s_waitcnt vmcnt(0)" ::: "memory");
        }
    }
    __syncthreads();
}

__global__ void __launch_bounds__(512, 2) mk_fwd(Args a) {
    extern __shared__ __attribute__((aligned(16))) unsigned char lds_raw[];
    LAS unsigned char* lds = (LAS unsigned char*)lds_raw;
    cg::grid_group grid = cg::this_grid();
    volatile LAS unsigned* misc = (volatile LAS unsigned*)(lds + 131072 + 320);
    if (threadIdx.x < 32) misc[threadIdx.x] = 0u;
    __syncthreads();
    XcdBarrier bar = xcd_barrier_post((unsigned*)(a.ws + WS_BAR), misc + 8);
    const int lo = a.ph_lo, hi = a.ph_hi, G = gridDim.x;
    unsigned char* ws = a.ws;
    const float* mod = (const float*)(ws + WS_MOD);
#define IN(k) (lo <= (k) && (k) < hi)
#define SEAM(k) do { if (IN(k) && IN((k) + 1)) { if ((k) == 0) grid.sync(); else xcd_barrier(bar); } } while (0)
    for (int es_ = 0; es_ < EXTRA_SYNCS; ++es_) xcd_barrier(bar);
    if (IN(0)) {
#pragma unroll 1
      for (int rep_ = 0; rep_ < 1 + ((DUPMASK >> 0) & 1); ++rep_) { p0_prep(a, lds); } } SEAM(0);
    if (IN(1)) {
#pragma unroll 1
      for (int rep_ = 0; rep_ < 1 + ((DUPMASK >> 1) & 1); ++rep_) { rows_phase<false>(a.in[I_X], (bf16*)a.out, nullptr, a.in[I_NORMG], mod + 1024, mod); } } SEAM(1);
    if (IN(2)) {
#pragma unroll 1
      for (int rep_ = 0; rep_ < 1 + ((DUPMASK >> 2) & 1); ++rep_) { pg8::Gemm g{(const bf16*)a.out, (const bf16*)(ws + WS_WIN), S, EIN, D, D, D, 30, 0}; pg8::StaticOrder so; so.init(S, EIN, G, (int)blockIdx.x);
        pg8::EpiBf16P E{(bf16*)(ws + WS_PROJ0), EIN}; pg8::gemm_phase<pg8::EpiBf16P, pg8::StaticOrder, true, true>(lds, g, so, E); } } SEAM(2);
    if (IN(3)) {
#pragma unroll 1
      for (int rep_ = 0; rep_ < 1 + ((DUPMASK >> 3) & 1); ++rep_) { lru_phase<false>(a, lds); if (PROBE_P4) lru_phase<true, true>(a, lds); } } SEAM(3);
    if (IN(4)) {
#pragma unroll 1
      for (int rep_ = 0; rep_ < 1 + ((DUPMASK >> 4) & 1); ++rep_) { lru_phase<true>(a, lds); } } SEAM(4);
    if (IN(5)) {
#pragma unroll 1
      for (int rep_ = 0; rep_ < 1 + ((DUPMASK >> 5) & 1); ++rep_) { pg8::Gemm g{(const bf16*)(ws + WS_PROJ0) + 1024, (const bf16*)(ws + WS_WOUT), S, D, 2048, EIN, 2048, 30, 0}; pg8::StaticOrder so; so.init(S, D, G, (int)blockIdx.x);
        pg8::EpiResGate E{a.in[I_X], a.out, mod + 2048, D}; pg8::gemm_phase<pg8::EpiResGate, pg8::StaticOrder, true, true>(lds, g, so, E); } } SEAM(5);
    if (IN(6)) {
#pragma unroll 1
      for (int rep_ = 0; rep_ < 1 + ((DUPMASK >> 6) & 1); ++rep_) { rows_phase<false>(a.out, (bf16*)(ws + WS_H1), nullptr, a.in[I_NORMG] + D, mod + 3072 + 1024, mod + 3072); } } SEAM(6);
    if (IN(7)) {
#pragma unroll 1
      for (int rep_ = 0; rep_ < 1 + ((DUPMASK >> 7) & 1); ++rep_) { pg8::Gemm g{(const bf16*)(ws + WS_H1), (const bf16*)(ws + WS_PWIN), S, 4096, D, D, D, 30, 0}; pg8::StaticOrder so; so.init(S, 4096, G, (int)blockIdx.x);
        pg8::EpiBf16P E{(bf16*)(ws + WS_PROJ1), 4096}; pg8::gemm_phase<pg8::EpiBf16P, pg8::StaticOrder, true, true>(lds, g, so, E); } } SEAM(7);
    if (IN(8)) {
#pragma unroll 1
      for (int rep_ = 0; rep_ < 1 + ((DUPMASK >> 8) & 1); ++rep_) { pool_phase(a); } } SEAM(8);
    if (IN(9)) {
#pragma unroll 1
      for (int rep_ = 0; rep_ < 1 + ((DUPMASK >> 9) & 1); ++rep_) { pg8::Gemm g{(const bf16*)(ws + WS_DP), (const bf16*)(ws + WS_PGRP), S, PW, 512, PW, 512, 1, 1024}; pg8::StaticOrder so; so.init(S, PW, G, (int)blockIdx.x);
        if (PROBE_P9) { pg8::EpiGrp Ep{(bf16*)(ws + WS_PROJ1) + 2048, 4096, a.in[I_PBGRP], a.in[I_PSCALE], (bf16*)(ws + WS_H1)}; pg8::gemm_phase<pg8::EpiGrp, pg8::StaticOrder, true, true>(lds, g, so, Ep); }
        pg8::EpiGrp E{(bf16*)(ws + WS_PROJ1) + 2048, 4096, a.in[I_PBGRP], a.in[I_PSCALE], nullptr}; pg8::gemm_phase<pg8::EpiGrp, pg8::StaticOrder, true, true>(lds, g, so, E); } } SEAM(9);
    if (IN(10)) {
#pragma unroll 1
      for (int rep_ = 0; rep_ < 1 + ((DUPMASK >> 10) & 1); ++rep_) { pg8::Gemm g{(const bf16*)(ws + WS_PROJ1) + 2048, (const bf16*)(ws + WS_PWOUT), S, D, 2048, 4096, 2048, 30, 0}; pg8::StaticOrder so; so.init(S, D, G, (int)blockIdx.x);
        pg8::EpiResGate E{a.out, a.out, mod + 3072 + 2048, D}; pg8::gemm_phase<pg8::EpiResGate, pg8::StaticOrder, true, true>(lds, g, so, E); } } SEAM(10);
    if (IN(11)) {
#pragma unroll 1
      for (int rep_ = 0; rep_ < 1 + ((DUPMASK >> 11) & 1); ++rep_) { rows_phase<true>(a.out, nullptr, a.out, a.in[I_FINALG], nullptr, nullptr); } }
#undef IN
#undef SEAM
}

extern "C" void kernel_launch(void* const* d_in, const int* in_sizes, int n_in, void* d_out, int out_size, void* d_ws, size_t ws_size, hipStream_t stream) {
    static int grid = 0;
    if (grid == 0) {
        if (n_in != 21 || out_size != S * D || ws_size < 256 * MiB) { fprintf(stderr, "kernel_launch: unexpected shapes (n_in %d out %d ws %zu)\n", n_in, out_size, ws_size); grid = -1; return; }
        int dev = 0, cus = 0, per_cu = 0;
        hipGetDevice(&dev); hipDeviceGetAttribute(&cus, hipDeviceAttributeMultiprocessorCount, dev);
        if (hipFuncSetAttribute((const void*)mk_fwd, hipFuncAttributeMaxDynamicSharedMemorySize, LDS_BYTES) != hipSuccess) { fprintf(stderr, "kernel_launch: hipFuncSetAttribute failed\n"); grid = -1; return; }
        if (hipOccupancyMaxActiveBlocksPerMultiprocessor(&per_cu, (const void*)mk_fwd, 512, LDS_BYTES) != hipSuccess || per_cu < 1) { fprintf(stderr, "kernel_launch: occupancy query says %d\n", per_cu); per_cu = 1; }
        (void)hipGetLastError();
        grid = cus * per_cu; if (grid > 256) grid = 256;
        fprintf(stderr, "kernel_launch: grid %d (cus %d per_cu %d)\n", grid, cus, per_cu);
    }
    if (grid < 0) return;
    Args a{};
    for (int i = 0; i < 21; ++i) a.in[i] = (const float*)d_in[i];
    a.out = (float*)d_out; a.ws = (unsigned char*)d_ws;
#if MK_N_LAUNCHES == 1
    a.ph_lo = 0; a.ph_hi = NPH;
    if (hipMemsetAsync((char*)d_ws + WS_BAR, 0, BAR_ZERO_BYTES, stream) != hipSuccess) { fprintf(stderr, "kernel_launch: memset failed\n"); return; }
    { void* args[] = {&a}; hipError_t e = hipLaunchCooperativeKernel((const void*)mk_fwd, dim3(grid), dim3(512), args, LDS_BYTES, stream);
      if (e != hipSuccess) fprintf(stderr, "kernel_launch: cooperative launch failed: %s (grid %d)\n", hipGetErrorString(e), grid); }
#else
    for (int ph = 0; ph < NPH; ++ph) { a.ph_lo = ph; a.ph_hi = ph + 1; hipLaunchKernelGGL(mk_fwd, dim3(grid), dim3(512), LDS_BYTES, stream, a); }
#endif
}
```

```cpp
#include <hip/hip_runtime.h>
#include <hip/hip_cooperative_groups.h>
#include <cstdio>
#include <cstdint>
namespace cg = cooperative_groups;
#ifndef DUPMASK
#define DUPMASK 0
#endif
#ifndef EXTRA_SYNCS
#define EXTRA_SYNCS 0
#endif
#ifndef PROBE_P4
#define PROBE_P4 0
#endif
#ifndef PROBE_P9
#define PROBE_P9 0
#endif
#ifndef TS_LO
#define TS_LO 0
#endif
#ifndef TS_HI
#define TS_HI 0
#endif
#ifndef MK_N_LAUNCHES
#define MK_N_LAUNCHES 1
#endif
namespace pg8 {
#define PG8_LAS __attribute__((address_space(3)))
typedef unsigned short bf16_t;
typedef short bf16x8 __attribute__((ext_vector_type(8)));
typedef float f32x4 __attribute__((ext_vector_type(4)));
typedef unsigned u32x4 __attribute__((ext_vector_type(4)));
constexpr int BM = 256, BK = 64, HALF = 128, HTB = HALF * BK * 2  , STAGE_BYTES = 8 * HTB, NXCD = 8, WGM = 8;

__host__ __device__ __forceinline__ int lds_byte(int r, int c) { const int st = (r >> 4) * 2 + (c >> 5), rr = r & 15, cc = c & 31, ob = rr * 64 + cc * 2; return st * 1024 + (ob ^ (((ob >> 9) & 1) << 5)); }
__host__ __device__ __forceinline__ void stage_rc(int b, int& R, int& C) { const int st = b / 1024, sb = b % 1024, swz = sb ^ (((sb >> 9) & 1) << 5); R = (st >> 1) * 16 + swz / 64; C = (st & 1) * 32 + (swz % 64) / 2; }
__host__ __device__ __forceinline__ int perm32(int rho) { const int n = rho >> 4, i = rho & 15; return 8 * (i >> 2) + 4 * n + (i & 3); }

struct Unit { int pm, pn; };
struct Gemm { const bf16_t* A; const bf16_t* Bt; int M, N, K, lda, ldb, a_pn_shift, a_pn_bytes, b_pm_shift, b_pm_bytes; };

struct StaticOrder {
    int nM, nN, nwg, G, c;
    __host__ __device__ void init(int M, int N, int G_, int c_) { nM = M / BM; nN = N / BM; nwg = nM * nN; G = G_; c = c_; }
    __host__ __device__ bool next(int i, Unit& u) const {
        const long L = (long)i * G + c; if (L >= nwg) return false;
        int wgid = (int)L; { const int q = nwg / NXCD, r = nwg % NXCD, xcd = wgid % NXCD, off = wgid / NXCD; wgid = (xcd < r ? xcd * (q + 1) : r * (q + 1) + (xcd - r) * q) + off; }
        const int nig = WGM * nN, gid = wgid / nig, fm = gid * WGM, gsz = (nM - fm) < WGM ? (nM - fm) : WGM;
        u.pm = fm + ((wgid % nig) % gsz); u.pn = (wgid % nig) / gsz; return true;
    }
    __device__ __forceinline__ void a_ready(const Unit&) const {}
    __device__ __forceinline__ void done(const Unit&) const {}
};
__device__ __forceinline__ unsigned cvt_pk_bf16(float lo, float hi) { unsigned r; asm volatile("v_cvt_pk_bf16_f32 %0, %1, %2" : "=v"(r) : "v"(lo), "v"(hi)); return r; }
}
namespace pg8 {
struct EpiBf16P {
    static constexpr bool PERM = true, AFTER_DRAIN = false;
    bf16_t* O; int ldc;
    __device__ __forceinline__ void operator()(const f32x4 (&acc)[2][2][4][2], const Unit& u, int wr, int wc, int fr, int fq) const {
        const int row0 = u.pm * BM + wr * 64 + fr, col0 = u.pn * BM + wc * 32 + 8 * fq;
#pragma unroll
        for (int ai = 0; ai < 2; ++ai)
#pragma unroll
            for (int m = 0; m < 4; ++m) { bf16_t* rowp = O + (size_t)(row0 + ai * HALF + m * 16) * ldc + col0;
#pragma unroll
                for (int bj = 0; bj < 2; ++bj) { const f32x4 v0 = acc[ai][bj][m][0], v1 = acc[ai][bj][m][1];
                    u32x4 w; w.x = cvt_pk_bf16(v0[0], v0[1]); w.y = cvt_pk_bf16(v0[2], v0[3]); w.z = cvt_pk_bf16(v1[0], v1[1]); w.w = cvt_pk_bf16(v1[2], v1[3]);
                    *(u32x4*)(rowp + bj * HALF) = w; } }
    }
};
struct EpiResGate {
    static constexpr bool PERM = false, AFTER_DRAIN = false;
    const float* base; float* out; const float* gate; int ldc;
    __device__ __forceinline__ void operator()(const f32x4 (&acc)[2][2][4][2], const Unit& u, int wr, int wc, int fr, int fq) const {
        const int row0 = u.pm * BM + wr * 64 + fr, col0 = u.pn * BM + wc * 32 + 4 * fq;
        f32x4 gv[2][2];
#pragma unroll
        for (int bj = 0; bj < 2; ++bj)
#pragma unroll
            for (int n = 0; n < 2; ++n) gv[bj][n] = *(const f32x4*)(gate + col0 + bj * HALF + n * 16);
#pragma unroll
        for (int ai = 0; ai < 2; ++ai)
#pragma unroll
            for (int m = 0; m < 4; ++m) { const size_t off = (size_t)(row0 + ai * HALF + m * 16) * ldc + col0;
#pragma unroll
                for (int bj = 0; bj < 2; ++bj)
#pragma unroll
                    for (int n = 0; n < 2; ++n) { const f32x4 bs = *(const f32x4*)(base + off + bj * HALF + n * 16); *(f32x4*)(out + off + bj * HALF + n * 16) = bs + gv[bj][n] * acc[ai][bj][m][n]; }
                asm volatile("" ::: "memory"); }
    }
};
struct EpiGrp {
    static constexpr bool PERM = true, AFTER_DRAIN = false;
    bf16_t* G; int ldc; const float* bias; const float* scale; bf16_t* probe;
    __device__ __forceinline__ void operator()(const f32x4 (&acc)[2][2][4][2], const Unit& u, int wr, int wc, int fr, int fq) const {
        const int row0 = u.pm * BM + wr * 64 + fr, col0 = u.pn * BM + wc * 32 + 8 * fq;
        f32x4 bv[2][2], sv[2][2];
#pragma unroll
        for (int bj = 0; bj < 2; ++bj)
#pragma unroll
            for (int n = 0; n < 2; ++n) { bv[bj][n] = *(const f32x4*)(bias + col0 + bj * HALF + 4 * n); sv[bj][n] = *(const f32x4*)(scale + col0 + bj * HALF + 4 * n); }
#pragma unroll
        for (int ai = 0; ai < 2; ++ai)
#pragma unroll
            for (int m = 0; m < 4; ++m) { bf16_t* rowp = G + (size_t)(row0 + ai * HALF + m * 16) * ldc + col0;
#pragma unroll
                for (int bj = 0; bj < 2; ++bj) { const u32x4 gw = *(const u32x4*)(rowp + bj * HALF);
                    const float g0 = __uint_as_float(gw.x << 16), g1 = __uint_as_float(gw.x & 0xffff0000u), g2 = __uint_as_float(gw.y << 16), g3 = __uint_as_float(gw.y & 0xffff0000u);
                    const float g4 = __uint_as_float(gw.z << 16), g5 = __uint_as_float(gw.z & 0xffff0000u), g6 = __uint_as_float(gw.w << 16), g7 = __uint_as_float(gw.w & 0xffff0000u);
                    const f32x4 s0 = (f32x4){g0, g1, g2, g3}, s1 = (f32x4){g4, g5, g6, g7};
                    f32x4 e0, e1;
#pragma unroll
                    for (int j = 0; j < 4; ++j) { e0[j] = s0[j] * __builtin_amdgcn_rcpf(1.0f + __builtin_amdgcn_exp2f(-s0[j] * 1.4426950408889634f)); e1[j] = s1[j] * __builtin_amdgcn_rcpf(1.0f + __builtin_amdgcn_exp2f(-s1[j] * 1.4426950408889634f)); }
                    const f32x4 v0 = (acc[ai][bj][m][0] + bv[bj][0]) * sv[bj][0] * e0, v1 = (acc[ai][bj][m][1] + bv[bj][1]) * sv[bj][1] * e1;
                    u32x4 w; w.x = cvt_pk_bf16(v0[0], v0[1]); w.y = cvt_pk_bf16(v0[2], v0[3]); w.z = cvt_pk_bf16(v1[0], v1[1]); w.w = cvt_pk_bf16(v1[2], v1[3]);
                    if (probe) *(u32x4*)(probe + (size_t)(row0 + ai * HALF + m * 16) * 1024 + ((col0 + bj * HALF) & 1023)) = w; else *(u32x4*)(rowp + bj * HALF) = w; } }
    }
};
template <class Epi, class Sched, bool ALIGN_EPI = false, bool SP2 = false>
__device__ __forceinline__ void gemm_phase(PG8_LAS unsigned char* lds, const Gemm g, const Sched& S, const Epi& E) {
    const int tid = threadIdx.x, wid = __builtin_amdgcn_readfirstlane(tid >> 6), lane = tid & 63, wr = wid >> 2, wc = wid & 3, fr = lane & 15, fq = lane >> 4;
    const int K = g.K, nt = K / BK, lda = g.lda, ldb = g.ldb;
    unsigned voffA[2], voffB[2];
#pragma unroll
    for (int i = 0; i < 2; ++i) { int R, C; stage_rc(tid * 16 + i * 8192, R, C); const int Rb = Epi::PERM ? ((R & ~31) + perm32(R & 31)) : R;
        voffA[i] = (unsigned)(R * lda + C) * 2u; voffB[i] = (unsigned)(Rb * ldb + C) * 2u; }
    const size_t kstep = (size_t)(BK * 2);
    const size_t hstepA = (size_t)HALF * lda * 2, hstepB = (size_t)HALF * ldb * 2;
    const size_t tstepA = 2 * hstepA, tstepB = 2 * hstepB;
    const unsigned ldsw = (unsigned)wid * 1024u;
    const int aoff = lds_byte(wr * 64 + fr, fq * 8), boff = lds_byte(wc * 32 + fr, fq * 8);
#define PG8_SA(b, h) (((b) * 2 + (h)) * HTB)
#define PG8_SB(b, h) ((4 + (b) * 2 + (h)) * HTB)
#define PG8_STAGE(bufoff, gbase, voff) do { _Pragma("unroll") for (int _i = 0; _i < 2; ++_i) \
        __builtin_amdgcn_global_load_lds((const unsigned*)((const char*)(gbase) + (voff)[_i]), (PG8_LAS unsigned*)(lds + (bufoff) + ldsw + _i * 8192), 16, 0, 0); } while (0)
#define PG8_LDA(dst, b, h) do { _Pragma("unroll") for (int m = 0; m < 4; ++m) _Pragma("unroll") for (int k = 0; k < 2; ++k) dst[m][k] = *(const PG8_LAS bf16x8*)(lds + PG8_SA(b, h) + aoff + m * 2048 + k * 1024); } while (0)
#define PG8_LDB(dst, b, h) do { _Pragma("unroll") for (int n = 0; n < 2; ++n) _Pragma("unroll") for (int k = 0; k < 2; ++k) dst[n][k] = *(const PG8_LAS bf16x8*)(lds + PG8_SB(b, h) + boff + n * 2048 + k * 1024); } while (0)
#define PG8_MMA(ai, bj, At, Bt) do { __builtin_amdgcn_s_setprio(1); _Pragma("unroll") for (int m = 0; m < 4; ++m) _Pragma("unroll") for (int n = 0; n < 2; ++n) _Pragma("unroll") for (int k = 0; k < 2; ++k) \
        acc[ai][bj][m][n] = __builtin_amdgcn_mfma_f32_16x16x32_bf16(Bt[n][k], At[m][k], acc[ai][bj][m][n], 0, 0, 0); __builtin_amdgcn_s_setprio(0); } while (0)
#define PG8_WAIT_V(n) asm volatile("s_waitcnt vmcnt(" #n ")" ::: "memory")
#define PG8_WAIT_L(n) asm volatile("s_waitcnt lgkmcnt(" #n ")" ::: "memory")
#define PG8_BAR __builtin_amdgcn_s_barrier()
#define PG8_SCHED __builtin_amdgcn_sched_barrier(0)
    Unit cur, nxt; int ui = 0;
    if (!S.next(0, cur)) return;
    f32x4 acc[2][2][4][2];
#pragma unroll
    for (int a = 0; a < 2; ++a)
#pragma unroll
        for (int b = 0; b < 2; ++b)
#pragma unroll
            for (int m = 0; m < 4; ++m)
#pragma unroll
                for (int n = 0; n < 2; ++n) acc[a][b][m][n] = (f32x4){0.f, 0.f, 0.f, 0.f};
    bf16x8 At[4][2], B0[2][2], B1[2][2];
    const char* cA = (const char*)g.A + (size_t)cur.pm * tstepA + (size_t)(cur.pn >> g.a_pn_shift) * g.a_pn_bytes; const char* cB = (const char*)g.Bt + (size_t)cur.pn * tstepB + (size_t)(cur.pm >> g.b_pm_shift) * g.b_pm_bytes;
    S.a_ready(cur);
    if constexpr (SP2) {
        PG8_STAGE(PG8_SB(0, 0), cB, voffB); PG8_STAGE(PG8_SB(0, 1), cB + hstepB, voffB); PG8_STAGE(PG8_SA(0, 0), cA, voffA); PG8_STAGE(PG8_SA(0, 1), cA + hstepA, voffA);
        if (wr == 1) PG8_BAR;
        PG8_WAIT_V(2); PG8_BAR;
        PG8_STAGE(PG8_SB(1, 0), cB + kstep, voffB); PG8_STAGE(PG8_SA(1, 0), cA + kstep, voffA); PG8_STAGE(PG8_SB(1, 1), cB + hstepB + kstep, voffB);
        PG8_WAIT_V(6); PG8_BAR;
    } else {
        PG8_STAGE(PG8_SB(0, 0), cB, voffB); PG8_STAGE(PG8_SA(0, 0), cA, voffA); PG8_STAGE(PG8_SB(0, 1), cB + hstepB, voffB); PG8_STAGE(PG8_SA(0, 1), cA + hstepA, voffA);
        if (wr == 1) PG8_BAR;
        PG8_WAIT_V(4); PG8_BAR;
        PG8_STAGE(PG8_SB(1, 0), cB + kstep, voffB); PG8_STAGE(PG8_SA(1, 0), cA + kstep, voffA); PG8_STAGE(PG8_SB(1, 1), cB + hstepB + kstep, voffB);
        PG8_WAIT_V(6); PG8_BAR;
    }
    for (;;) {
        const bool has_next = S.next(ui + 1, nxt);
        const char* nA = has_next ? (const char*)g.A + (size_t)nxt.pm * tstepA + (size_t)(nxt.pn >> g.a_pn_shift) * g.a_pn_bytes : cA; const char* nB = has_next ? (const char*)g.Bt + (size_t)nxt.pn * tstepB + (size_t)(nxt.pm >> g.b_pm_shift) * g.b_pm_bytes : cB;
        for (int t = 0; t < nt; t += 2) {
            const bool last = (t == nt - 2);
            const char* a1 = cA + (size_t)(t + 1) * kstep;
            const char* a2 = last ? nA : cA + (size_t)(t + 2) * kstep; const char* b2 = last ? nB : cB + (size_t)(t + 2) * kstep;
            const char* a3 = a2 + kstep; const char* b3 = b2 + kstep;
            if (last && has_next) S.a_ready(nxt);
            if constexpr (SP2) {
            PG8_LDB(B0, 0, 0); PG8_LDB(B1, 0, 1); PG8_SCHED; PG8_LDA(At, 0, 0); PG8_STAGE(PG8_SA(1, 1), a1 + hstepA, voffA);
            PG8_WAIT_V(8); PG8_WAIT_L(0); PG8_BAR; PG8_MMA(0, 0, At, B0); PG8_MMA(0, 1, At, B1); PG8_BAR; PG8_SCHED;
            PG8_LDA(At, 0, 1); PG8_STAGE(PG8_SB(0, 0), b2, voffB); PG8_STAGE(PG8_SB(0, 1), b2 + hstepB, voffB); PG8_STAGE(PG8_SA(0, 0), a2, voffA);
            PG8_WAIT_V(8); PG8_WAIT_L(0); PG8_BAR; PG8_MMA(1, 0, At, B0); PG8_MMA(1, 1, At, B1); PG8_BAR; PG8_SCHED;
            PG8_LDB(B0, 1, 0); PG8_LDB(B1, 1, 1); PG8_SCHED; PG8_LDA(At, 1, 0); PG8_STAGE(PG8_SA(0, 1), a2 + hstepA, voffA);
            PG8_WAIT_V(8); PG8_WAIT_L(0); PG8_BAR; PG8_MMA(0, 0, At, B0); PG8_MMA(0, 1, At, B1); PG8_BAR; PG8_SCHED;
            PG8_LDA(At, 1, 1); PG8_STAGE(PG8_SB(1, 0), b3, voffB); PG8_STAGE(PG8_SB(1, 1), b3 + hstepB, voffB); PG8_STAGE(PG8_SA(1, 0), a3, voffA);
            PG8_WAIT_V(8); PG8_WAIT_L(0); PG8_BAR; PG8_MMA(1, 0, At, B0); PG8_MMA(1, 1, At, B1); PG8_BAR; PG8_SCHED;
            } else {
            PG8_LDB(B0, 0, 0); PG8_SCHED; PG8_LDA(At, 0, 0); PG8_STAGE(PG8_SA(1, 1), a1 + hstepA, voffA);
            PG8_WAIT_L(8); PG8_BAR; PG8_WAIT_L(0); PG8_MMA(0, 0, At, B0); PG8_BAR; PG8_SCHED;
            PG8_LDB(B1, 0, 1); PG8_STAGE(PG8_SB(0, 0), b2, voffB);
            PG8_BAR; PG8_WAIT_L(0); PG8_MMA(0, 1, At, B1); PG8_BAR;
            PG8_LDA(At, 0, 1); PG8_STAGE(PG8_SA(0, 0), a2, voffA);
            PG8_BAR; PG8_WAIT_L(0); PG8_MMA(1, 0, At, B0); PG8_BAR; PG8_SCHED;
            PG8_STAGE(PG8_SB(0, 1), b2 + hstepB, voffB);
            PG8_WAIT_V(6); PG8_BAR; PG8_MMA(1, 1, At, B1); PG8_BAR;
            PG8_LDB(B0, 1, 0); PG8_SCHED; PG8_LDA(At, 1, 0); PG8_STAGE(PG8_SA(0, 1), a2 + hstepA, voffA);
            PG8_WAIT_L(8); PG8_BAR; PG8_WAIT_L(0); PG8_MMA(0, 0, At, B0); PG8_BAR; PG8_SCHED;
            PG8_LDB(B1, 1, 1); PG8_STAGE(PG8_SB(1, 0), b3, voffB);
            PG8_BAR; PG8_WAIT_L(0); PG8_MMA(0, 1, At, B1); PG8_BAR;
            PG8_LDA(At, 1, 1); PG8_STAGE(PG8_SA(1, 0), a3, voffA);
            PG8_BAR; PG8_WAIT_L(0); PG8_MMA(1, 0, At, B0); PG8_BAR; PG8_SCHED;
            PG8_STAGE(PG8_SB(1, 1), b3 + hstepB, voffB);
            PG8_WAIT_V(6); PG8_BAR; PG8_MMA(1, 1, At, B1); PG8_BAR;
            }
        }
        if constexpr (ALIGN_EPI) { if (wr == 0) PG8_BAR; }
        if constexpr (!Epi::AFTER_DRAIN) { E(acc, cur, wr, wc, fr, fq); S.done(cur); }
        if (!has_next) break;
#pragma unroll
        for (int a = 0; a < 2; ++a)
#pragma unroll
            for (int b = 0; b < 2; ++b)
#pragma unroll
                for (int m = 0; m < 4; ++m)
#pragma unroll
                    for (int n = 0; n < 2; ++n) acc[a][b][m][n] = (f32x4){0.f, 0.f, 0.f, 0.f};
        cur = nxt; cA = nA; cB = nB; ++ui;
        if constexpr (ALIGN_EPI) { if (wr == 1) PG8_BAR; }
    }
    PG8_WAIT_V(0);
    if constexpr (!ALIGN_EPI) { if (wr == 0) PG8_BAR; }
    PG8_BAR;
    if constexpr (Epi::AFTER_DRAIN) { E.fused(acc, cur, wr, wc, fr, fq, lds, wid, lane); S.done(cur); }
#undef PG8_SA
#undef PG8_SB
#undef PG8_STAGE
#undef PG8_LDA
#undef PG8_LDB
#undef PG8_MMA
#undef PG8_WAIT_V
#undef PG8_WAIT_L
#undef PG8_BAR
#undef PG8_SCHED
}
}
constexpr int S = 16384, D = 1024, EIN = 6144, PW = 2048, NPH = 12;
constexpr float EPS = 1e-6f, LOG2E = 1.4426950408889634f;
constexpr size_t MiB = 1u << 20;
constexpr size_t WS_MOD = 0;
constexpr size_t WS_BAR = 2 * MiB, BAR_ZERO_BYTES = 16384;
constexpr size_t WS_AGG = 1 * MiB;
constexpr size_t WS_WIN = 4 * MiB;
constexpr size_t WS_WOUT = 16 * MiB;
constexpr size_t WS_PWIN = 20 * MiB;
constexpr size_t WS_PGRP = 28 * MiB;
constexpr size_t WS_PWOUT = 30 * MiB;
constexpr size_t WS_LWA = 34 * MiB;
constexpr size_t WS_LWX = 34 * MiB + 512 * 1024;
constexpr size_t WS_PROJ0 = 36 * MiB;
constexpr size_t WS_H1 = 224 * MiB;
constexpr size_t WS_PROJ1 = 36 * MiB;
constexpr size_t WS_PWINV = 228 * MiB;
constexpr int LDS_BYTES = 147456;

#define LAS __attribute__((address_space(3)))
typedef unsigned short bf16;
typedef float f32x4 __attribute__((ext_vector_type(4)));
typedef unsigned u32x4 __attribute__((ext_vector_type(4)));
typedef unsigned u32x2 __attribute__((ext_vector_type(2)));
typedef short bf16x8 __attribute__((ext_vector_type(8)));
using pg8::cvt_pk_bf16;
__device__ __forceinline__ float bf2f(unsigned short b) { return __uint_as_float(((unsigned)b) << 16); }
__device__ __forceinline__ float bflo(unsigned w) { return __uint_as_float(w << 16); }
__device__ __forceinline__ float bfhi(unsigned w) { return __uint_as_float(w & 0xffff0000u); }
__device__ __forceinline__ unsigned short f2bf(float f) { unsigned u = __float_as_uint(f); return (unsigned short)((u + 0x7fffu + ((u >> 16) & 1u)) >> 16); }
__device__ __forceinline__ float sigmoidf_(float x) { return __builtin_amdgcn_rcpf(1.0f + __builtin_amdgcn_exp2f(-x * LOG2E)); }
__device__ __forceinline__ float siluf_(float x) { return x * sigmoidf_(x); }
__device__ __forceinline__ float wave_sum(float v) {
#pragma unroll
    for (int o = 1; o < 64; o <<= 1) v += __shfl_xor(v, o);
    return v;
}
__device__ __forceinline__ void unpack8(const u32x4 w, float (&f)[8]) { f[0] = bflo(w.x); f[1] = bfhi(w.x); f[2] = bflo(w.y); f[3] = bfhi(w.y); f[4] = bflo(w.z); f[5] = bfhi(w.z); f[6] = bflo(w.w); f[7] = bfhi(w.w); }
__device__ __forceinline__ u32x4 pack8(const float (&f)[8]) { u32x4 w; w.x = cvt_pk_bf16(f[0], f[1]); w.y = cvt_pk_bf16(f[2], f[3]); w.z = cvt_pk_bf16(f[4], f[5]); w.w = cvt_pk_bf16(f[6], f[7]); return w; }

struct Args { const float* in[21]; float* out; unsigned char* ws; int ph_lo, ph_hi; };
enum { I_X = 0, I_C, I_NORMG, I_MODW, I_MODB, I_HYWIN, I_CONVW, I_CONVB, I_LWA, I_LBA, I_LWX, I_LBX, I_LAM, I_SCW, I_HYWOUT, I_PWIN, I_PGRP, I_PBGRP, I_PSCALE, I_PWOUT, I_FINALG };

__device__ __forceinline__ void transpose_item(const float* W, int N, int k0, int n0, bf16* WT, int ldt, int drow0, LAS float* scr, int lane) {
#pragma unroll 8
    for (int i = 0; i < 32; ++i) { const int kk = 2 * i + (lane >> 5); scr[kk * 33 + (lane & 31)] = W[(size_t)(k0 + kk) * N + n0 + (lane & 31)]; }
    asm volatile("s_waitcnt lgkmcnt(0)" ::: "memory");
    const int c = lane & 7;
#pragma unroll
    for (int j = 0; j < 4; ++j) { const int n = (lane >> 3) + 8 * j; const LAS float* s = scr + (8 * c) * 33 + n;
        u32x4 o; o.x = cvt_pk_bf16(s[0 * 33], s[1 * 33]); o.y = cvt_pk_bf16(s[2 * 33], s[3 * 33]); o.z = cvt_pk_bf16(s[4 * 33], s[5 * 33]); o.w = cvt_pk_bf16(s[6 * 33], s[7 * 33]);
        *(u32x4*)(WT + (size_t)(drow0 + n) * ldt + k0 + 8 * c) = o; }
    asm volatile("s_waitcnt lgkmcnt(0)" ::: "memory");
}
__device__ __forceinline__ void p0_prep(const Args& a, LAS unsigned char* lds) {
    const int tid = threadIdx.x, lane = tid & 63, w = __builtin_amdgcn_readfirstlane(tid >> 6);
    unsigned char* ws = a.ws;
    { LAS float* red = (LAS float*)lds; float* mod = (float*)(ws + WS_MOD);
      for (int it = blockIdx.x; it < 96; it += gridDim.x) {
        const int l = it / 48, cgp = it % 48; const float* Wp = a.in[I_MODW] + (size_t)l * D * 3072 + 64 * cgp + lane; const float* cp = a.in[I_C];
        float acc = 0.f;
#pragma unroll 8
        for (int kk = 0; kk < 128; ++kk) { const int k = 128 * w + kk; const float cv = cp[k]; acc += siluf_(cv) * Wp[(size_t)k * 3072]; }
        red[w * 64 + lane] = acc; __syncthreads();
        if (w == 0) { float s = 0.f;
#pragma unroll
            for (int i = 0; i < 8; ++i) s += red[i * 64 + lane];
            mod[l * 3072 + 64 * cgp + lane] = s + a.in[I_MODB][l * 3072 + 64 * cgp + lane]; }
        __syncthreads(); } }
    LAS float* scr = (LAS float*)(lds + w * 16384);
    const int gw = blockIdx.x * 8 + w, NGW = gridDim.x * 8;
    constexpr int I0 = 16 * 192, I1 = 32 * 32, I2 = 16 * 64, I3 = 4 * 128, I4 = 32 * 32, I5 = 16 * 8, NIT = I0 + I1 + I2 + I3 + I4 + I5;
    for (int it = gw; it < NIT; it += NGW) {
        int r = it;
        if (r < I0) { const int kb = r / 192, nb = r % 192, n0 = 32 * nb, sb = n0 >> 10; const int db = (sb == 0) ? 0 : (sb == 1) ? 1 : (sb == 5) ? 2 : sb + 1;
            transpose_item(a.in[I_HYWIN], EIN, 64 * kb, n0, (bf16*)(ws + WS_WIN), D, db * 1024 + (n0 & 1023), scr, lane); continue; } r -= I0;
        if (r < I1) { const int kb = r / 32, nb = r % 32; transpose_item(a.in[I_HYWOUT], D, 64 * kb, 32 * nb, (bf16*)(ws + WS_WOUT), 2048, 32 * nb, scr, lane); continue; } r -= I1;
        if (r < I2) { const int kb = r / 64, nb = 64 + r % 64; transpose_item(a.in[I_PWIN], 4096, 64 * kb, 32 * nb, (bf16*)(ws + WS_PWIN), D, 32 * nb, scr, lane); continue; } r -= I2;
        if (r < I3) { const int g = r / 128, q = r % 128, kb = q / 16, nb = q % 16; transpose_item(a.in[I_PGRP] + (size_t)g * 512 * 512, 512, 64 * kb, 32 * nb, (bf16*)(ws + WS_PGRP) + (size_t)g * 512 * 512, 512, 32 * nb, scr, lane); continue; } r -= I3;
        if (r < I4) { const int kb = r / 32, nb = r % 32; transpose_item(a.in[I_PWOUT], D, 64 * kb, 32 * nb, (bf16*)(ws + WS_PWOUT), 2048, 32 * nb, scr, lane); continue; } r -= I4;
        { const int m = r / 8, q = r % 8, kb = q / 4, nb = q % 4; const float* src = (m < 8 ? a.in[I_LWA] : a.in[I_LWX]) + (size_t)(m & 7) * 128 * 128;
          bf16* dst = (bf16*)(ws + (m < 8 ? WS_LWA : WS_LWX)) + (size_t)(m & 7) * 128 * 128; transpose_item(src, 128, 64 * kb, 32 * nb, dst, 128, 32 * nb, scr, lane); }
    }
    for (int idx = blockIdx.x * 512 + tid; idx < 1024 * 512; idx += gridDim.x * 512) { const int row = idx >> 9, c4 = idx & 511; const f32x4 v = *(const f32x4*)(a.in[I_PWIN] + (size_t)row * 4096 + 4 * c4);
        u32x2 pk; pk.x = cvt_pk_bf16(v.x, v.y); pk.y = cvt_pk_bf16(v.z, v.w); *(u32x2*)((bf16*)(ws + WS_PWINV) + (size_t)row * 2048 + 4 * c4) = pk; }
}

template <bool FINAL>
__device__ __forceinline__ void rows_phase(const float* X, bf16* H, float* OUT, const float* g, const float* scale, const float* shift) {
    const int tid = threadIdx.x, lane = tid & 63, w = tid >> 6; const int gw = blockIdx.x * 8 + w, NGW = gridDim.x * 8;
    f32x4 gs[4], sh[4];
#pragma unroll
    for (int j = 0; j < 4; ++j) { const int col = 4 * lane + 256 * j; gs[j] = *(const f32x4*)(g + col);
        if (!FINAL) { gs[j] = gs[j] * (*(const f32x4*)(scale + col) + 1.0f); sh[j] = *(const f32x4*)(shift + col); } else sh[j] = (f32x4){0.f, 0.f, 0.f, 0.f}; }
    for (int m = gw; m < S; m += NGW) {
        const f32x4* xr = (const f32x4*)(X + (size_t)m * D) + lane; f32x4 v[4]; float s = 0.f;
#pragma unroll
        for (int j = 0; j < 4; ++j) { v[j] = xr[64 * j]; s += (v[j].x * v[j].x + v[j].y * v[j].y) + (v[j].z * v[j].z + v[j].w * v[j].w); }
        const float rstd = 1.0f / sqrtf(wave_sum(s) * (1.0f / D) + EPS);
        if (FINAL) { f32x4* o = (f32x4*)(OUT + (size_t)m * D) + lane;
#pragma unroll
            for (int j = 0; j < 4; ++j) o[64 * j] = v[j] * rstd * gs[j]; }
        else { u32x2* o = (u32x2*)(H + (size_t)m * D) + lane;
#pragma unroll
            for (int j = 0; j < 4; ++j) { const f32x4 y = v[j] * rstd * gs[j] + sh[j]; u32x2 pk; pk.x = cvt_pk_bf16(y.x, y.y); pk.y = cvt_pk_bf16(y.z, y.w); o[64 * j] = pk; } }
    }
}
template <bool FINAL, bool PROBE = false>
__device__ __forceinline__ void lru_phase(const Args& a, LAS unsigned char* lds) {
    const int tid = threadIdx.x, lane = tid & 63, w = __builtin_amdgcn_readfirstlane(tid >> 6), fr = lane & 15, fq = lane >> 4;
    LAS bf16* Abf = (LAS bf16*)lds;
    LAS float* xcT = (LAS float*)(lds + 17408);
    LAS float* hbuf = (LAS float*)(lds + 17408 + 34816);
    bf16* proj0 = (bf16*)(a.ws + WS_PROJ0);
    const bf16* wa_t = (const bf16*)(a.ws + WS_LWA); const bf16* wx_t = (const bf16*)(a.ws + WS_LWX);
    float* agg = (float*)(a.ws + WS_AGG);
    for (int item = blockIdx.x; item < 256; item += gridDim.x) {
        const int hd = item & 7, sc = item >> 3;
        const int cc = tid & 127, q = tid >> 7, gch = hd * 128 + cc;
        const float cw0 = a.in[I_CONVW][gch], cw1 = a.in[I_CONVW][1024 + gch], cw2 = a.in[I_CONVW][2048 + gch], cw3 = a.in[I_CONVW][3072 + gch], cb = a.in[I_CONVB][gch];
        const int ch = hd * 128 + 16 * w + fr;
        const float ba = a.in[I_LBA][ch], bx = a.in[I_LBX][ch];
        const float k8 = -8.0f * log1pf(expf(-a.in[I_LAM][ch])) * LOG2E;
        bf16x8 wa[4], wx[4];
#pragma unroll
        for (int kk = 0; kk < 4; ++kk) { wa[kk] = *(const bf16x8*)(wa_t + (size_t)(hd * 128 + 16 * w + fr) * 128 + 32 * kk + 8 * fq); wx[kk] = *(const bf16x8*)(wx_t + (size_t)(hd * 128 + 16 * w + fr) * 128 + 32 * kk + 8 * fq); }
        float hin = 0.f, Atot = 1.f;
        if (FINAL) { for (int s = 0; s < sc; ++s) { const float2 ab = *(const float2*)(agg + ((size_t)s * 1024 + ch) * 2); hin = ab.x * hin + ab.y; } }
        for (int st = 0; st < 8; ++st) {
            const int t0 = sc * 512 + st * 64;
            { const int tb = t0 + 16 * q; const bf16* xp = proj0 + (size_t)tb * EIN + gch;
              float x0 = 0.f, x1 = 0.f, x2 = 0.f;
              if (tb > 0) { x0 = bf2f(xp[-3 * EIN]); x1 = bf2f(xp[-2 * EIN]); x2 = bf2f(xp[-1 * EIN]); }
              f32x4 v;
#pragma unroll
              for (int i = 0; i < 16; ++i) { const float x3 = bf2f(xp[(size_t)i * EIN]); const float xc = cw0 * x0 + cw1 * x1 + cw2 * x2 + cw3 * x3 + cb;
                  Abf[(16 * q + i) * 136 + cc] = f2bf(xc); v[i & 3] = xc; if ((i & 3) == 3) *(LAS f32x4*)(xcT + cc * 68 + 16 * q + i - 3) = v;
                  x0 = x1; x1 = x2; x2 = x3; } }
            __syncthreads();
#pragma unroll 1
            for (int mb = 0; mb < 4; ++mb) {
                f32x4 ar = (f32x4){0.f, 0.f, 0.f, 0.f}, ai = (f32x4){0.f, 0.f, 0.f, 0.f};
#pragma unroll
                for (int kk = 0; kk < 4; ++kk) { const bf16x8 af = *(const LAS bf16x8*)(Abf + (16 * mb + fr) * 136 + 32 * kk + 8 * fq);
                    ar = __builtin_amdgcn_mfma_f32_16x16x32_bf16(af, wa[kk], ar, 0, 0, 0); ai = __builtin_amdgcn_mfma_f32_16x16x32_bf16(af, wx[kk], ai, 0, 0, 0); }
                const f32x4 xcv = *(const LAS f32x4*)(xcT + (16 * w + fr) * 68 + 16 * mb + 4 * fq);
                float P[4], H[4];
#pragma unroll
                for (int j = 0; j < 4; ++j) { const float r = sigmoidf_(ar[j] + ba), ig = sigmoidf_(ai[j] + bx); const float av = __builtin_amdgcn_exp2f(r * k8);
                    float mult = sqrtf(fmaxf(1.0f - av * av, 0.f)); if (t0 + 16 * mb + 4 * fq + j == 0) mult = 1.0f;
                    const float uv = mult * ig * xcv[j];
                    if (j == 0) { P[0] = av; H[0] = uv; } else { P[j] = P[j - 1] * av; H[j] = av * H[j - 1] + uv; } }
                float A = P[3], B = H[3];
                float A1 = __shfl_up(A, 16), B1 = __shfl_up(B, 16); if (fq >= 1) { B = A * B1 + B; A = A * A1; }
                A1 = __shfl_up(A, 32); B1 = __shfl_up(B, 32); if (fq >= 2) { B = A * B1 + B; A = A * A1; }
                float Ae = __shfl_up(A, 16), Be = __shfl_up(B, 16); if (fq == 0) { Ae = 1.f; Be = 0.f; }
                const float hs = Ae * hin + Be;
                const float At = __shfl(A, 48 + fr), Bt = __shfl(B, 48 + fr);
                if (FINAL) {
#pragma unroll
                    for (int j = 0; j < 4; ++j) hbuf[(16 * mb + 4 * fq + j) * 132 + 16 * w + fr] = P[j] * hs + H[j]; }
                hin = At * hin + Bt; Atot *= At;
            }
            __syncthreads();
            if (FINAL) {
#pragma unroll 1
                for (int rep = 0; rep < 2; ++rep) { const int id = tid + 512 * rep, t = id >> 4, s = id & 15; const int tg = t0 + t; const int c8 = hd * 128 + 8 * s;
                    bf16* rowp = proj0 + (size_t)tg * EIN + c8;
                    const f32x4 h0 = *(const LAS f32x4*)(hbuf + t * 132 + 8 * s), h1 = *(const LAS f32x4*)(hbuf + t * 132 + 8 * s + 4);
                    float gaf[8], o[8]; unpack8(*(const u32x4*)(rowp + 1024), gaf);
#pragma unroll
                    for (int e = 0; e < 4; ++e) { o[e] = h0[e] * siluf_(gaf[e]); o[4 + e] = h1[e] * siluf_(gaf[4 + e]); }
                    if (PROBE) *(u32x4*)((bf16*)a.out + (size_t)S * D + (size_t)tg * D + c8) = pack8(o); else *(u32x4*)(rowp + 1024) = pack8(o);
                    float gbf[8], gpf[8], c0[8], c1[8], c2[8], vv[8], cv[8];
                    unpack8(*(const u32x4*)(rowp + 2048), gbf); unpack8(*(const u32x4*)(rowp + 3072), gpf);
                    unpack8(*(const u32x4*)(rowp + 4096), c2); unpack8(*(const u32x4*)(rowp + 5120), vv);
#pragma unroll
                    for (int e = 0; e < 8; ++e) cv[e] = a.in[I_SCW][2048 + c8 + e] * (c2[e] * vv[e]);
                    if (tg >= 1) { unpack8(*(const u32x4*)(rowp - EIN + 4096), c1); unpack8(*(const u32x4*)(rowp - EIN + 5120), vv);
#pragma unroll
                        for (int e = 0; e < 8; ++e) cv[e] += a.in[I_SCW][1024 + c8 + e] * (c1[e] * vv[e]); }
                    if (tg >= 2) { unpack8(*(const u32x4*)(rowp - 2 * EIN + 4096), c0); unpack8(*(const u32x4*)(rowp - 2 * EIN + 5120), vv);
#pragma unroll
                        for (int e = 0; e < 8; ++e) cv[e] += a.in[I_SCW][c8 + e] * (c0[e] * vv[e]); }
#pragma unroll
                    for (int e = 0; e < 8; ++e) o[e] = gpf[e] * cv[e] * siluf_(gbf[e]);
                    if (PROBE) *(u32x4*)((bf16*)a.out + (size_t)S * D + (size_t)tg * D + c8) = pack8(o); else *(u32x4*)(rowp + 2048) = pack8(o);
                }
            }
        }
        if (!FINAL && fq == 0) *(float2*)(agg + ((size_t)sc * 1024 + ch) * 2) = make_float2(Atot, hin);
    }
}

__device__ __forceinline__ void pool_phase(const Args& a) {
    bf16* proj1 = (bf16*)(a.ws + WS_PROJ1);
    for (int task = blockIdx.x * 512 + threadIdx.x; task < 256 * 512; task += gridDim.x * 512) {
        const int strip = task & 255, run = task >> 8, col = 8 * strip, W = 2 << (col >> 9), t0 = run * 32;
        float sum[8], cur[8], old[8], bb[8], ss[8];
#pragma unroll
        for (int e = 0; e < 8; ++e) { sum[e] = 0.f; bb[e] = a.in[I_PBGRP][col + e]; ss[e] = a.in[I_PSCALE][col + e]; }
        for (int i = 1; i <= W; ++i) { const int t = t0 - i; if (t >= 0) { unpack8(*(const u32x4*)(proj1 + (size_t)t * 4096 + col), cur);
#pragma unroll
            for (int e = 0; e < 8; ++e) sum[e] += cur[e]; } }
#pragma unroll 4
        for (int i = 0; i < 32; ++i) { const int t = t0 + i; unpack8(*(const u32x4*)(proj1 + (size_t)t * 4096 + col), cur);
            float gv[8]; unpack8(*(const u32x4*)(proj1 + (size_t)t * 4096 + 2048 + col), gv);
#pragma unroll
            for (int e = 0; e < 8; ++e) sum[e] += cur[e];
            if (t - W >= 0) { unpack8(*(const u32x4*)(proj1 + (size_t)(t - W) * 4096 + col), old);
#pragma unroll
                for (int e = 0; e < 8; ++e) sum[e] -= old[e]; }
            const int cnt = (t + 1 < W) ? t + 1 : W; const float inv = 1.0f / (float)cnt; float o[8];
#pragma unroll
            for (int e = 0; e < 8; ++e) o[e] = (sum[e] * inv - cur[e] + bb[e]) * ss[e] * siluf_(gv[e]);
            *(u32x4*)(proj1 + (size_t)t * 4096 + 2048 + col) = pack8(o); }
    }
}

#define RLX_AGENT __ATOMIC_RELAXED, __HIP_MEMORY_SCOPE_AGENT
#define XB_TMO      128
#define XB_XCNT(j)  (256  + 64 * (j))
#define XB_XSUB(j)  (1280 + 64 * (j))
#define XB_XGEN(j)  (2304 + 64 * (j))
#define XB_TOP      3328
#define XB_TOPGEN   3392
#define XCD_BAR_WORDS 3456
#define XB_SPIN_CAP (1u << 18)

__device__ __forceinline__ unsigned xb_ld(unsigned* p)              { return __hip_atomic_load(p, __ATOMIC_RELAXED, __HIP_MEMORY_SCOPE_AGENT); }
__device__ __forceinline__ unsigned xb_add(unsigned* p, unsigned v) { return __hip_atomic_fetch_add(p, v, __ATOMIC_RELAXED, __HIP_MEMORY_SCOPE_AGENT); }
__device__ __forceinline__ unsigned xb_xcc_id() { return (unsigned)__builtin_amdgcn_s_getreg((3 << 11) | 20) & 0xFu; }
#define XB_SPIN(cond, bar) do { unsigned _sp = 0; while (cond) { __builtin_amdgcn_s_sleep(1); \
    if ((++_sp & 255u) == 0u) { if (xb_ld(&(bar)[XB_TMO])) break; if (_sp > XB_SPIN_CAP) { atomicAdd(&(bar)[XB_TMO], 1u); break; } } } } while (0)

struct XcdBarrier {
    unsigned* bar; unsigned x;
    volatile LAS unsigned* st;
};

__device__ __forceinline__ XcdBarrier xcd_barrier_post(unsigned* bar, volatile LAS unsigned* st) {
    XcdBarrier b; b.bar = bar; b.x = xb_xcc_id(); b.st = st;
    if (threadIdx.x == 0) (void)xb_add(&bar[XB_XCNT(b.x)], 1u);
    return b;
}
__device__ __forceinline__ void xcd_barrier_complete(unsigned* bar, unsigned x, unsigned& nloc, unsigned& nx) {
    const unsigned G = gridDim.x * gridDim.y * gridDim.z;
    unsigned sum, cnt, mine, sp = 0u;
    for (;;) {
        sum = 0u; cnt = 0u; mine = 0u;
#pragma unroll
        for (unsigned j = 0; j < 16; ++j) { const unsigned c = xb_ld(&bar[XB_XCNT(j)]); sum += c; cnt += (c > 0u) ? 1u : 0u; mine = (j == x) ? c : mine; }
        if (sum == G) break;
        __builtin_amdgcn_s_sleep(1);
        if ((++sp & 255u) == 0u) { if (xb_ld(&bar[XB_TMO])) break; if (sp > XB_SPIN_CAP) { atomicAdd(&bar[XB_TMO], 1u); break; } }
    }
    nloc = mine > 0u ? mine : 1u; nx = cnt > 0u ? cnt : 1u;
}

__device__ __forceinline__ void xcd_barrier(const XcdBarrier& b) {
    asm volatile("s_waitcnt vmcnt(0)" ::: "memory");
    __syncthreads();
    if (threadIdx.x == 0) {
        unsigned* bar = b.bar;
        __builtin_amdgcn_s_waitcnt(0);
        unsigned nloc = b.st[0], nx = b.st[1];
        if (nloc == 0u) { xcd_barrier_complete(bar, b.x, nloc, nx); b.st[0] = nloc; b.st[1] = nx; }
        const unsigned old = xb_add(&bar[XB_XSUB(b.x)], 1u);
        const unsigned gen = old / nloc;
        if (old + 1u == (gen + 1u) * nloc) {
            __builtin_amdgcn_fence(__ATOMIC_RELEASE, "agent");
            asm volatile("s_waitcnt vmcnt(0)" ::: "memory");
            const unsigned og = xb_add(&bar[XB_TOP], 1u);
            const unsigned tg = og / nx;
            if (og + 1u == (tg + 1u) * nx) xb_add(&bar[XB_TOPGEN], 1u);
            else XB_SPIN(xb_ld(&bar[XB_TOPGEN]) == tg, bar);
            __builtin_amdgcn_fence(__ATOMIC_ACQUIRE, "agent");
            xb_add(&bar[XB_XGEN(b.x)], 1u);
            asm volatile("s_waitcnt vmcnt(0)" ::: "memory");
        } else {
            XB_SPIN(xb_ld(&bar[XB_XGEN(b.x)]) == gen, bar);
            __builtin_amdgcn_fence(__ATOMIC_ACQUIRE, "agent");
            asm volatile("s_waitcnt vmcnt(0)" ::: "memory");
        }
    }
    __syncthreads();
}

__global__ void __launch_bounds__(512, 2) mk_fwd(Args a) {
    extern __shared__ __attribute__((aligned(16))) unsigned char lds_raw[];
    LAS unsigned char* lds = (LAS unsigned char*)lds_raw;
    cg::grid_group grid = cg::this_grid();
    volatile LAS unsigned* misc = (volatile LAS unsigned*)(lds + 131072 + 320);
    if (threadIdx.x < 32) misc[threadIdx.x] = 0u;
    __syncthreads();
    XcdBarrier bar = xcd_barrier_post((unsigned*)(a.ws + WS_BAR), misc + 8);
    const int lo = a.ph_lo, hi = a.ph_hi, G = gridDim.x;
    unsigned char* ws = a.ws;
    const float* mod = (const float*)(ws + WS_MOD);
#define IN(k) (lo <= (k) && (k) < hi)
    unsigned long long ts0_ = 0, ts1_ = 0;
#define TSB(k) do { if (TS_HI > TS_LO && (k) == TS_LO) ts0_ = __builtin_amdgcn_s_memrealtime(); } while (0)
#define TSE(k) do { if (TS_HI > TS_LO && (k) + 1 == TS_HI) ts1_ = __builtin_amdgcn_s_memrealtime(); } while (0)
#define SEAM(k) do { if (IN(k) && IN((k) + 1)) { if ((k) == 0) grid.sync(); else xcd_barrier(bar); } } while (0)
    for (int es_ = 0; es_ < EXTRA_SYNCS; ++es_) xcd_barrier(bar);
    TSB(0); if (IN(0)) {
#pragma unroll 1
      for (int rep_ = 0; rep_ < 1 + ((DUPMASK >> 0) & 1); ++rep_) { p0_prep(a, lds); } } SEAM(0); TSE(0);
    TSB(1); if (IN(1)) {
#pragma unroll 1
      for (int rep_ = 0; rep_ < 1 + ((DUPMASK >> 1) & 1); ++rep_) { { pg8::Gemm gw{(const bf16*)(ws + WS_PGRP), (const bf16*)(ws + WS_PWINV), PW, D, 512, 512, 2048, 30, 0, 1, 1024}; pg8::StaticOrder sw; sw.init(PW, D, G, (int)blockIdx.x);
          pg8::EpiBf16P Ew{(bf16*)(ws + WS_PWIN), D}; pg8::gemm_phase<pg8::EpiBf16P, pg8::StaticOrder, true, true>(lds, gw, sw, Ew); }
        rows_phase<false>(a.in[I_X], (bf16*)a.out, nullptr, a.in[I_NORMG], mod + 1024, mod); } } SEAM(1); TSE(1);
    TSB(2); if (IN(2)) {
#pragma unroll 1
      for (int rep_ = 0; rep_ < 1 + ((DUPMASK >> 2) & 1); ++rep_) { pg8::Gemm g{(const bf16*)a.out, (const bf16*)(ws + WS_WIN), S, EIN, D, D, D, 30, 0, 30, 0}; pg8::StaticOrder so; so.init(S, EIN, G, (int)blockIdx.x);
        pg8::EpiBf16P E{(bf16*)(ws + WS_PROJ0), EIN}; pg8::gemm_phase<pg8::EpiBf16P, pg8::StaticOrder, true, true>(lds, g, so, E); } } SEAM(2); TSE(2);
    TSB(3); if (IN(3)) {
#pragma unroll 1
      for (int rep_ = 0; rep_ < 1 + ((DUPMASK >> 3) & 1); ++rep_) { lru_phase<false>(a, lds); if (PROBE_P4) lru_phase<true, true>(a, lds); } } SEAM(3); TSE(3);
    TSB(4); if (IN(4)) {
#pragma unroll 1
      for (int rep_ = 0; rep_ < 1 + ((DUPMASK >> 4) & 1); ++rep_) { lru_phase<true>(a, lds); } } SEAM(4); TSE(4);
    TSB(5); if (IN(5)) {
#pragma unroll 1
      for (int rep_ = 0; rep_ < 1 + ((DUPMASK >> 5) & 1); ++rep_) { pg8::Gemm g{(const bf16*)(ws + WS_PROJ0) + 1024, (const bf16*)(ws + WS_WOUT), S, D, 2048, EIN, 2048, 30, 0, 30, 0}; pg8::StaticOrder so; so.init(S, D, G, (int)blockIdx.x);
        pg8::EpiResGate E{a.in[I_X], a.out, mod + 2048, D}; pg8::gemm_phase<pg8::EpiResGate, pg8::StaticOrder, true, true>(lds, g, so, E); } } SEAM(5); TSE(5);
    TSB(6); if (IN(6)) {
#pragma unroll 1
      for (int rep_ = 0; rep_ < 1 + ((DUPMASK >> 6) & 1); ++rep_) { rows_phase<false>(a.out, (bf16*)(ws + WS_H1), nullptr, a.in[I_NORMG] + D, mod + 3072 + 1024, mod + 3072); } } SEAM(6); TSE(6);
    TSB(7); if (IN(7)) {
#pragma unroll 1
      for (int rep_ = 0; rep_ < 1 + ((DUPMASK >> 7) & 1); ++rep_) { pg8::Gemm g{(const bf16*)(ws + WS_H1), (const bf16*)(ws + WS_PWIN), S, 4096, D, D, D, 30, 0, 30, 0}; pg8::StaticOrder so; so.init(S, 4096, G, (int)blockIdx.x);
        pg8::EpiBf16P E{(bf16*)(ws + WS_PROJ1), 4096}; pg8::gemm_phase<pg8::EpiBf16P, pg8::StaticOrder, true, true>(lds, g, so, E); } } SEAM(7); TSE(7);
    TSB(8); if (IN(8)) {
#pragma unroll 1
      for (int rep_ = 0; rep_ < 1 + ((DUPMASK >> 8) & 1); ++rep_) { pool_phase(a); } } SEAM(8); TSE(8);
    TSB(10); if (IN(10)) {
#pragma unroll 1
      for (int rep_ = 0; rep_ < 1 + ((DUPMASK >> 10) & 1); ++rep_) { pg8::Gemm g{(const bf16*)(ws + WS_PROJ1) + 2048, (const bf16*)(ws + WS_PWOUT), S, D, 2048, 4096, 2048, 30, 0, 30, 0}; pg8::StaticOrder so; so.init(S, D, G, (int)blockIdx.x);
        pg8::EpiResGate E{a.out, a.out, mod + 3072 + 2048, D}; pg8::gemm_phase<pg8::EpiResGate, pg8::StaticOrder, true, true>(lds, g, so, E); } } SEAM(10); TSE(10);
    TSB(11); if (IN(11)) {
#pragma unroll 1
      for (int rep_ = 0; rep_ < 1 + ((DUPMASK >> 11) & 1); ++rep_) { rows_phase<true>(a.out, nullptr, a.out, a.in[I_FINALG], nullptr, nullptr); } } TSE(11);
    if (TS_HI > TS_LO && blockIdx.x == 0 && threadIdx.x == 0) { const unsigned long long d_ = ts1_ - ts0_, s_ = __builtin_amdgcn_s_memrealtime(); while (__builtin_amdgcn_s_memrealtime() - s_ < d_) __builtin_amdgcn_s_sleep(4); }
#undef IN
#undef SEAM
}

extern "C" void kernel_launch(void* const* d_in, const int* in_sizes, int n_in, void* d_out, int out_size, void* d_ws, size_t ws_size, hipStream_t stream) {
    static int grid = 0;
    if (grid == 0) {
        if (n_in != 21 || out_size != S * D || ws_size < 256 * MiB) { fprintf(stderr, "kernel_launch: unexpected shapes (n_in %d out %d ws %zu)\n", n_in, out_size, ws_size); grid = -1; return; }
        int dev = 0, cus = 0, per_cu = 0;
        hipGetDevice(&dev); hipDeviceGetAttribute(&cus, hipDeviceAttributeMultiprocessorCount, dev);
        if (hipFuncSetAttribute((const void*)mk_fwd, hipFuncAttributeMaxDynamicSharedMemorySize, LDS_BYTES) != hipSuccess) { fprintf(stderr, "kernel_launch: hipFuncSetAttribute failed\n"); grid = -1; return; }
        if (hipOccupancyMaxActiveBlocksPerMultiprocessor(&per_cu, (const void*)mk_fwd, 512, LDS_BYTES) != hipSuccess || per_cu < 1) { fprintf(stderr, "kernel_launch: occupancy query says %d\n", per_cu); per_cu = 1; }
        (void)hipGetLastError();
        grid = cus * per_cu; if (grid > 256) grid = 256;
        fprintf(stderr, "kernel_launch: grid %d (cus %d per_cu %d)\n", grid, cus, per_cu);
    }
    if (grid < 0) return;
    Args a{};
    for (int i = 0; i < 21; ++i) a.in[i] = (const float*)d_in[i];
    a.out = (float*)d_out; a.ws = (unsigned char*)d_ws;
#if MK_N_LAUNCHES == 1
    a.ph_lo = 0; a.ph_hi = NPH;
    if (hipMemsetAsync((char*)d_ws + WS_BAR, 0, BAR_ZERO_BYTES, stream) != hipSuccess) { fprintf(stderr, "kernel_launch: memset failed\n"); return; }
    { void* args[] = {&a}; hipError_t e = hipLaunchCooperativeKernel((const void*)mk_fwd, dim3(grid), dim3(512), args, LDS_BYTES, stream);
      if (e != hipSuccess) fprintf(stderr, "kernel_launch: cooperative launch failed: %s (grid %d)\n", hipGetErrorString(e), grid); }
#else
    for (int ph = 0; ph < NPH; ++ph) { a.ph_lo = ph; a.ph_hi = ph + 1; hipLaunchKernelGGL(mk_fwd, dim3(grid), dim3(512), LDS_BYTES, stream, a); }
#endif
}
```
